# Optimizing an MI355X kernel written in HIP

```python
import math
import jax
import jax.numpy as jnp
from jax import lax
import numpy as np

D_MODEL = 1024
BATCH = 8
SEQ = 8192
DEPTH = 1

D_SSD = D_MODEL
SSD_HEAD_DIM = 64
N_SSD_HEADS = D_SSD // SSD_HEAD_DIM
N_GROUPS = 2
HEADS_PER_GROUP = N_SSD_HEADS // N_GROUPS
D_STATE = 128
SSD_CONV = 4
CHUNK = 128
D_XBC = D_SSD + 2 * N_GROUPS * D_STATE
D_SC = D_MODEL
SC_GROUP_DIM = 64
N_SC_GROUPS = D_SC // SC_GROUP_DIM
SC_CONV = 3
D_MIX = D_SSD + D_SC
PROJ_SPLITS = (D_SSD, D_SSD + D_XBC, D_SSD + D_XBC + N_SSD_HEADS,
               D_SSD + D_XBC + N_SSD_HEADS + D_SC, D_SSD + D_XBC + N_SSD_HEADS + 2 * D_SC)
PROJ_DIM = D_SSD + D_XBC + N_SSD_HEADS + 3 * D_SC
N_EXPERTS = 32
TOP_K = 4
EXPERT_FF = D_MODEL
SWIGLU_LIMIT = 7.0
SWIGLU_ALPHA = 1.702
EXPERT_BLOCK = 256
EPS = 1e-5

kernel_name = 'hybrid_ssd_shortconv_moe'


def rms_norm(x, w):
    xf = x.astype(jnp.float32)
    y = xf * lax.rsqrt(jnp.mean(xf * xf, axis=-1, keepdims=True) + EPS)
    return (y * w.astype(jnp.float32)).astype(x.dtype)


def gated_group_rms_norm(y, z, w, n_groups):
    g = (y * jax.nn.silu(z)).astype(jnp.float32)
    shp = g.shape
    g = g.reshape(*shp[:-1], n_groups, shp[-1] // n_groups)
    g = g * lax.rsqrt(jnp.mean(g * g, axis=-1, keepdims=True) + EPS)
    return (g.reshape(shp) * w.astype(jnp.float32)).astype(y.dtype)


def causal_depthwise_conv(u, w):
    k, c = w.shape
    return lax.conv_general_dilated(
        u, w[:, None, :], window_strides=(1,), padding=[(k - 1, 0)],
        dimension_numbers=('NWC', 'WIO', 'NWC'), feature_group_count=c)


def ssd_chunked_scan(xdt, adt, bm, cm):
    b, s = xdt.shape[:2]
    nc = s // CHUNK

    def to_chunks(t):
        return jnp.moveaxis(t.reshape(b, nc, CHUNK, *t.shape[2:]), 1, 0)

    causal = jnp.tril(jnp.ones((CHUNK, CHUNK), dtype=bool))[None, :, :, None, None]

    def step(state, inp):
        xc, ac, bc, cc = inp
        acum = jnp.cumsum(ac, axis=1)
        seg = acum[:, :, None] - acum[:, None]
        decay_in = jnp.exp(jnp.where(causal, seg, -jnp.inf))
        cb = jnp.einsum('bign,bjgn->bijg', cc, bc)
        y_intra = jnp.einsum('bijg,bijge,bjgep->bigep', cb, decay_in, xc)
        y_inter = jnp.einsum('bign,bgepn->bigep', cc, state) * jnp.exp(acum)[..., None]
        decay_out = jnp.exp(acum[:, -1:] - acum)
        new_state = (state * jnp.exp(acum[:, -1])[..., None, None]
                     + jnp.einsum('bjgn,bjge,bjgep->bgepn', bc, decay_out, xc))
        return new_state, y_intra + y_inter

    state0 = jnp.zeros((b, N_GROUPS, HEADS_PER_GROUP, SSD_HEAD_DIM, D_STATE), jnp.float32)
    _, y = lax.scan(step, state0, (to_chunks(xdt), to_chunks(adt), to_chunks(bm), to_chunks(cm)))
    return jnp.moveaxis(y, 0, 1).reshape(b, s, N_GROUPS, HEADS_PER_GROUP, SSD_HEAD_DIM)


def mixer_block(xn, w_in, ssd_conv_w, ssd_conv_b, dt_bias, a_log, d_skip, ssd_norm_w,
                sc_conv_w, sc_norm_w, w_out):
    b, s, _ = xn.shape
    proj = xn @ w_in
    z, xbc, dt_raw, g_b, g_c, u = jnp.split(proj, PROJ_SPLITS, axis=-1)
    xbc = jax.nn.silu(causal_depthwise_conv(xbc, ssd_conv_w) + ssd_conv_b)
    xs, bs, cs = jnp.split(xbc, [D_SSD, D_SSD + N_GROUPS * D_STATE], axis=-1)
    dt = jax.nn.softplus(dt_raw.astype(jnp.float32) + dt_bias.astype(jnp.float32))
    a = -jnp.exp(a_log.astype(jnp.float32))
    xs_h = xs.astype(jnp.float32).reshape(b, s, N_GROUPS, HEADS_PER_GROUP, SSD_HEAD_DIM)
    dt_h = dt.reshape(b, s, N_GROUPS, HEADS_PER_GROUP)
    y = ssd_chunked_scan(
        xs_h * dt_h[..., None],
        dt_h * a.reshape(N_GROUPS, HEADS_PER_GROUP),
        bs.astype(jnp.float32).reshape(b, s, N_GROUPS, D_STATE),
        cs.astype(jnp.float32).reshape(b, s, N_GROUPS, D_STATE))
    y = y + d_skip.astype(jnp.float32).reshape(N_GROUPS, HEADS_PER_GROUP)[..., None] * xs_h
    y_ssd = gated_group_rms_norm(y.reshape(b, s, D_SSD).astype(xn.dtype), z, ssd_norm_w, N_GROUPS)
    v = causal_depthwise_conv(g_c * u, sc_conv_w)
    y_sc = rms_norm(g_b * v, sc_norm_w)
    return jnp.concatenate([y_ssd, y_sc], axis=-1) @ w_out


def moe_block(xn, w_router, b_router, w_gate_up, b_gate_up, w_down, b_down):
    b, s, d = xn.shape
    t = b * s
    xf = xn.reshape(t, d)
    logits = (xf @ w_router + b_router).astype(jnp.float32)
    top_logit, top_idx = lax.top_k(logits, TOP_K)
    gates = jax.nn.softmax(top_logit, axis=-1)
    n_assign = t * TOP_K
    flat_e = top_idx.reshape(n_assign).astype(jnp.int32)
    flat_tok = jnp.arange(n_assign, dtype=jnp.int32) // TOP_K
    flat_g = gates.reshape(n_assign)
    order = jnp.argsort(flat_e)
    se = flat_e[order]
    counts = jnp.bincount(flat_e, length=N_EXPERTS).astype(jnp.int32)
    starts = jnp.cumsum(counts) - counts
    pcounts = (counts + EXPERT_BLOCK - 1) // EXPERT_BLOCK * EXPERT_BLOCK
    pends = jnp.cumsum(pcounts)
    pstarts = pends - pcounts
    dest = pstarts[se] + jnp.arange(n_assign, dtype=jnp.int32) - starts[se]
    n_rows = n_assign + N_EXPERTS * EXPERT_BLOCK
    n_blocks = n_rows // EXPERT_BLOCK
    row_tok = jnp.zeros((n_rows,), jnp.int32).at[dest].set(flat_tok[order])
    row_gate = jnp.zeros((n_rows,), jnp.float32).at[dest].set(flat_g[order])
    block_start = jnp.arange(n_blocks, dtype=jnp.int32) * EXPERT_BLOCK
    blk_e = jnp.minimum(jnp.searchsorted(pends, block_start, side='right'), N_EXPERTS - 1)

    def expert_block(args):
        tok, g, e = args
        xb = xf[tok]
        gu = xb @ w_gate_up[e] + b_gate_up[e]
        gate, up = gu[:, :EXPERT_FF], gu[:, EXPERT_FF:]
        gate = jnp.minimum(gate, SWIGLU_LIMIT)
        up = jnp.clip(up, -SWIGLU_LIMIT, SWIGLU_LIMIT)
        hid = (up + 1.0) * (gate * jax.nn.sigmoid(SWIGLU_ALPHA * gate))
        out = hid @ w_down[e] + b_down[e]
        return (out * g[:, None]).astype(xf.dtype)

    outs = lax.map(expert_block, (row_tok.reshape(n_blocks, EXPERT_BLOCK),
                                  row_gate.reshape(n_blocks, EXPERT_BLOCK), blk_e))
    y = jnp.zeros_like(xf).at[row_tok].add(outs.reshape(n_rows, d))
    return y.reshape(b, s, d)


def setup_inputs(seed: int = 0) -> dict:
    key = jax.random.key(seed)
    ks = jax.random.split(key, 20)
    L, D, E, F = DEPTH, D_MODEL, N_EXPERTS, EXPERT_FF
    nrm = jax.random.normal
    x = nrm(ks[0], (BATCH, SEQ, D), jnp.float32)
    norm1_w = 1.0 + 0.02 * nrm(ks[1], (L, D), jnp.float32)
    col_scale = jnp.ones((PROJ_DIM,), jnp.float32).at[PROJ_SPLITS[1]:PROJ_SPLITS[2]].set(0.1)
    w_in = nrm(ks[2], (L, D, PROJ_DIM), jnp.float32) * (D ** -0.5) * col_scale
    ssd_conv_w = nrm(ks[3], (L, SSD_CONV, D_XBC), jnp.float32) * (SSD_CONV ** -0.5)
    ssd_conv_b = 0.02 * nrm(ks[4], (L, D_XBC), jnp.float32)
    dt0 = jnp.exp(jax.random.uniform(ks[5], (L, N_SSD_HEADS), jnp.float32,
                                     math.log(1e-3), math.log(1e-1)))
    dt_bias = dt0 + jnp.log(-jnp.expm1(-dt0))
    a_log = jnp.log(jax.random.uniform(ks[6], (L, N_SSD_HEADS), jnp.float32, 1.0, 16.0))
    d_skip = 1.0 + 0.1 * nrm(ks[7], (L, N_SSD_HEADS), jnp.float32)
    ssd_norm_w = 1.0 + 0.02 * nrm(ks[8], (L, D_SSD), jnp.float32)
    sc_conv_w = nrm(ks[9], (L, SC_CONV, D_SC), jnp.float32) * (SC_CONV ** -0.5)
    sc_norm_w = 1.0 + 0.02 * nrm(ks[10], (L, D_SC), jnp.float32)
    w_out = nrm(ks[11], (L, D_MIX, D), jnp.float32) * (D_MIX ** -0.5)
    norm2_w = 1.0 + 0.02 * nrm(ks[12], (L, D), jnp.float32)
    w_router = nrm(ks[13], (L, D, E), jnp.float32) * (D ** -0.5)
    b_router = 0.01 * nrm(ks[14], (L, E), jnp.float32)
    w_gate_up = nrm(ks[15], (L, E, D, 2 * F), jnp.float32) * (D ** -0.5)
    b_gate_up = 0.01 * nrm(ks[16], (L, E, 2 * F), jnp.float32)
    w_down = nrm(ks[17], (L, E, F, D), jnp.float32) * (F ** -0.5)
    b_down = 0.01 * nrm(ks[18], (L, E, D), jnp.float32)
    final_norm_w = 1.0 + 0.02 * nrm(ks[19], (D,), jnp.float32)
    return {'x': x, 'norm1_w': norm1_w, 'w_in': w_in, 'ssd_conv_w': ssd_conv_w,
            'ssd_conv_b': ssd_conv_b, 'dt_bias': dt_bias, 'a_log': a_log, 'd_skip': d_skip,
            'ssd_norm_w': ssd_norm_w, 'sc_conv_w': sc_conv_w, 'sc_norm_w': sc_norm_w,
            'w_out': w_out, 'norm2_w': norm2_w, 'w_router': w_router, 'b_router': b_router,
            'w_gate_up': w_gate_up, 'b_gate_up': b_gate_up, 'w_down': w_down, 'b_down': b_down,
            'final_norm_w': final_norm_w}


def reference(x, norm1_w, w_in, ssd_conv_w, ssd_conv_b, dt_bias, a_log, d_skip, ssd_norm_w,
              sc_conv_w, sc_norm_w, w_out, norm2_w, w_router, b_router, w_gate_up, b_gate_up,
              w_down, b_down, final_norm_w):
    h = x
    for l in range(DEPTH):
        xn = rms_norm(h, norm1_w[l])
        h = h + mixer_block(xn, w_in[l], ssd_conv_w[l], ssd_conv_b[l], dt_bias[l], a_log[l],
                            d_skip[l], ssd_norm_w[l], sc_conv_w[l], sc_norm_w[l], w_out[l])
        xn = rms_norm(h, norm2_w[l])
        h = h + moe_block(xn, w_router[l], b_router[l], w_gate_up[l], b_gate_up[l],
                          w_down[l], b_down[l])
    return rms_norm(h, final_norm_w)
```

```cpp
#include <hip/hip_runtime.h>
#include <cstdio>
#include <cstdint>

#ifndef FAST
#define FAST 0x1FF
#endif
#ifndef N_LAUNCHES
#define N_LAUNCHES 1
#endif

#define GAS __attribute__((address_space(1)))
#define LAS __attribute__((address_space(3)))
typedef unsigned short bf16;
typedef unsigned v4u __attribute__((ext_vector_type(4)));
typedef unsigned v2u __attribute__((ext_vector_type(2)));
typedef unsigned long long u64;
typedef float f32x4 __attribute__((ext_vector_type(4)));
typedef float f32x2 __attribute__((ext_vector_type(2)));
typedef short bf16x8 __attribute__((ext_vector_type(8)));

constexpr int D = 1024, NBATCH = 8, SEQ = 8192, T = NBATCH * SEQ;
constexpr int NH = 16, HD = 64, NG = 2, HPG = 8, DST = 128, CHK = 128, NCHK = SEQ / CHK;
constexpr int DXBC = 1536, NPROJ = 5632, PROJ_DIM = 5648, DT_COL0 = 2560;
constexpr int NE = 32, FF = 1024;
constexpr float EPS = 1e-5f, SWI_LIMIT = 7.0f, SWI_ALPHA = 1.702f;
constexpr int XN_LD = 1088, WIN_LD = 1088, G2_LD = 2112, WOUT_LD = 2112;
constexpr int ENT_CAP = 65536;
constexpr int HID_ROWS = 270336;
enum { I_X = 0, I_N1W, I_WIN, I_SCW, I_SCB, I_DTB, I_ALOG, I_DSKIP, I_SNW, I_SCCW, I_SCNW, I_WOUT, I_N2W, I_WR, I_BR, I_WGU, I_BGU, I_WD, I_BD, I_FNW };

constexpr size_t MiB = 1u << 20;
constexpr size_t WS_CTL = 0, CTL_ZERO_BYTES = 1 * MiB;
constexpr size_t WS_DT = 1 * MiB;
constexpr size_t WS_CDEC = 5 * MiB;
constexpr size_t WS_RINV = 5 * MiB + 512 * 1024;
constexpr size_t WS_WIN = 6 * MiB;
constexpr size_t WS_WOUT = 18 * MiB;
constexpr size_t WS_ENT = 23 * MiB;
constexpr size_t WS_WD = 40 * MiB;
constexpr size_t WS_WGU = 104 * MiB;
constexpr size_t WS_Z = 232 * MiB;
constexpr size_t WS_XBC = 360 * MiB;
constexpr size_t WS_G2 = 552 * MiB;
constexpr size_t WS_U = 816 * MiB;
constexpr size_t WS_XN2 = 232 * MiB;
constexpr size_t WS_HID = 360 * MiB;
constexpr size_t SLOT_SKEW = 1 * MiB + 68 * 1024 + 256;
constexpr size_t WS_SLOT0 = 624 * MiB, WS_SLOT1 = 72 * MiB + SLOT_SKEW, WS_SLOT2 = 200 * MiB + 2 * SLOT_SKEW, WS_SLOT3 = 752 * MiB + 3 * SLOT_SKEW;
constexpr size_t WS_END = 1016 * MiB;
constexpr size_t WS_ERINV = WS_WIN;
static_assert((size_t)NE * ENT_CAP * 4 <= (size_t)NPROJ * WIN_LD * 2, "erinv fits in the dead in-projection weights");
static_assert(WS_WIN + (size_t)NPROJ * WIN_LD * 2 <= WS_WOUT && WS_WOUT + (size_t)D * WOUT_LD * 2 <= WS_ENT && WS_ENT + (size_t)NE * ENT_CAP * 8 <= WS_WD && WS_G2 + (size_t)T * G2_LD * 2 <= WS_U && WS_U + (size_t)T * D * 2 <= WS_END && (size_t)T * XN_LD * 2 <= 256 * MiB, "padded layout");
static_assert(WS_HID + (size_t)HID_ROWS * FF <= WS_SLOT0 && WS_SLOT0 + (size_t)T * D * 2 <= WS_SLOT3 && WS_SLOT3 + (size_t)T * D * 2 <= WS_END, "slot 0 sits between the fp8 hid buffer and slot 3");
static_assert(WS_WD + (size_t)NE * D * FF <= WS_SLOT1 && WS_SLOT1 + (size_t)T * D * 2 <= WS_SLOT2 && WS_SLOT2 + (size_t)T * D * 2 <= WS_HID, "slots 1, 2 sit between the fp8 down weights and the hid buffer");
constexpr size_t DO_XN = 0;
constexpr size_t DO_S = 128 * MiB;
constexpr size_t DO_XC = 0;
constexpr int CW_BAR = 0, CW_GCOUNT = 4096;

constexpr int NWAVES = 8, NTHREADS = 512;
constexpr int LDS_BYTES = 160 * 1024;

struct Args { const float* in[20]; float* out; unsigned char* ws; int ph_lo, ph_hi, pad0, pad1; };

__device__ __forceinline__ unsigned f2bf(float f) { unsigned u = __builtin_bit_cast(unsigned, f); return (u + 0x7fffu + ((u >> 16) & 1u)) >> 16; }
__device__ __forceinline__ unsigned pk2(float lo, float hi) { return f2bf(lo) | (f2bf(hi) << 16); }
__device__ __forceinline__ unsigned pk2_hw(float lo, float hi) { return pk2(lo, hi); }
__device__ __forceinline__ float bflo(unsigned w) { return __builtin_bit_cast(float, w << 16); }
__device__ __forceinline__ float bfhi(unsigned w) { return __builtin_bit_cast(float, w & 0xffff0000u); }
__device__ __forceinline__ float bf2f(bf16 b) { return __builtin_bit_cast(float, ((unsigned)b) << 16); }
__device__ __forceinline__ float wave_sum(float v) {
#pragma unroll
    for (int o = 1; o < 64; o <<= 1) v += __shfl_xor(v, o);
    return v;
}
__device__ __forceinline__ float silu_f(float x) { return x / (1.0f + __expf(-x)); }
__device__ __forceinline__ float silu_fast(float x) { return x * __builtin_amdgcn_rcpf(1.0f + __builtin_amdgcn_exp2f(x * -1.44269504f)); }
__device__ __forceinline__ float softplus_f(float x) { return fmaxf(x, 0.0f) + log1pf(expf(-fabsf(x))); }
__device__ __forceinline__ int lane_id() { return (int)__builtin_amdgcn_mbcnt_hi(~0u, __builtin_amdgcn_mbcnt_lo(~0u, 0u)); }
__device__ __forceinline__ int lane_id_v() { int l; asm volatile("v_mbcnt_lo_u32_b32 %0, -1, 0\n\tv_mbcnt_hi_u32_b32 %0, -1, %0" : "=v"(l)); return l; }
__device__ __forceinline__ float bperm(float v, int src) { return __builtin_bit_cast(float, __builtin_amdgcn_ds_bpermute(src << 2, __builtin_bit_cast(int, v))); }
#define LDS_WAIT() asm volatile("s_waitcnt lgkmcnt(0)" ::: "memory")
#define VM_WAIT() asm volatile("s_waitcnt vmcnt(0)" ::: "memory")

#define XB_TMO      128
#define XB_XCNT(j)  (256  + 64 * (j))
#define XB_XSUB(j)  (1280 + 64 * (j))
#define XB_XGEN(j)  (2304 + 64 * (j))
#define XB_TOP      3328
#define XB_TOPGEN   3392
#define XCD_BAR_WORDS 3456
#define XB_SPIN_CAP (1u << 18)
__device__ __forceinline__ unsigned xb_ld(unsigned* p)              { return __hip_atomic_load(p, __ATOMIC_RELAXED, __HIP_MEMORY_SCOPE_AGENT); }
__device__ __forceinline__ unsigned xb_add(unsigned* p, unsigned v) { return __hip_atomic_fetch_add(p, v, __ATOMIC_RELAXED, __HIP_MEMORY_SCOPE_AGENT); }
__device__ __forceinline__ unsigned xb_xcc_id() { return (unsigned)__builtin_amdgcn_s_getreg((3 << 11) | 20) & 0xFu; }
#define XB_SPIN(cond, bar) do { unsigned _sp = 0; while (cond) { __builtin_amdgcn_s_sleep(1); \
    if ((++_sp & 255u) == 0u) { if (xb_ld(&(bar)[XB_TMO])) break; if (_sp > XB_SPIN_CAP) { atomicAdd(&(bar)[XB_TMO], 1u); break; } } } } while (0)
struct XcdBarrier { unsigned* bar; unsigned x; volatile LAS unsigned* st; int wave; };
__device__ __forceinline__ XcdBarrier xcd_barrier_post(unsigned* bar, volatile LAS unsigned* st, int wave) {
    XcdBarrier b; b.bar = bar; b.x = xb_xcc_id(); b.st = st; b.wave = wave;
    if (wave == 0 && lane_id() == 0) (void)xb_add(&bar[XB_XCNT(b.x)], 1u);
    return b;
}
__device__ __forceinline__ void xcd_barrier_complete(unsigned* bar, unsigned x, unsigned& nloc, unsigned& nx) {
    const unsigned G = gridDim.x * gridDim.y * gridDim.z;
    unsigned sum, cnt, mine, sp = 0u;
    for (;;) {
        sum = 0u; cnt = 0u; mine = 0u;
#pragma unroll
        for (unsigned j = 0; j < 16; ++j) { const unsigned c = xb_ld(&bar[XB_XCNT(j)]); sum += c; cnt += (c > 0u) ? 1u : 0u; mine = (j == x) ? c : mine; }
        if (sum == G) break;
        __builtin_amdgcn_s_sleep(1);
        if ((++sp & 255u) == 0u) { if (xb_ld(&bar[XB_TMO])) break; if (sp > XB_SPIN_CAP) { atomicAdd(&bar[XB_TMO], 1u); break; } }
    }
    nloc = mine > 0u ? mine : 1u; nx = cnt > 0u ? cnt : 1u;
}
__device__ __forceinline__ void xcd_barrier(const XcdBarrier& b) {
    asm volatile("s_waitcnt vmcnt(0)" ::: "memory");
    __syncthreads();
    if (b.wave == 0 && lane_id() == 0) {
        unsigned* bar = b.bar;
        __builtin_amdgcn_s_waitcnt(0);
        unsigned nloc = b.st[0], nx = b.st[1];
        if (nloc == 0u) { xcd_barrier_complete(bar, b.x, nloc, nx); b.st[0] = nloc; b.st[1] = nx; }
        const unsigned old = xb_add(&bar[XB_XSUB(b.x)], 1u);
        const unsigned gen = old / nloc;
        if (old + 1u == (gen + 1u) * nloc) {
            __builtin_amdgcn_fence(__ATOMIC_RELEASE, "agent");
            asm volatile("s_waitcnt vmcnt(0)" ::: "memory");
            const unsigned og = xb_add(&bar[XB_TOP], 1u);
            const unsigned tg = og / nx;
            if (og + 1u == (tg + 1u) * nx) xb_add(&bar[XB_TOPGEN], 1u);
            else XB_SPIN(xb_ld(&bar[XB_TOPGEN]) == tg, bar);
            __builtin_amdgcn_fence(__ATOMIC_ACQUIRE, "agent");
            xb_add(&bar[XB_XGEN(b.x)], 1u);
            asm volatile("s_waitcnt vmcnt(0)" ::: "memory");
        } else {
            XB_SPIN(xb_ld(&bar[XB_XGEN(b.x)]) == gen, bar);
            __builtin_amdgcn_fence(__ATOMIC_ACQUIRE, "agent");
            asm volatile("s_waitcnt vmcnt(0)" ::: "memory");
        }
    }
    __syncthreads();
}

__device__ __forceinline__ void p0_transpose_item(const float* W, int ldsrc, int ksrc0, int nsrc0, bf16* WT, int lddst, int ndst0, int kdst0, LAS float* scr, int lane) {
#pragma unroll 8
    for (int i = 0; i < 32; ++i) { const int kk = 2 * i + (lane >> 5); scr[kk * 33 + (lane & 31)] = W[(size_t)(ksrc0 + kk) * ldsrc + nsrc0 + (lane & 31)]; }
    LDS_WAIT(); asm volatile("" ::: "memory");
    const int c = lane & 7;
#pragma unroll
    for (int j = 0; j < 4; ++j) { const int n = (lane >> 3) + 8 * j; const LAS float* s = scr + (8 * c) * 33 + n;
        v4u o; o.x = pk2(s[0 * 33], s[1 * 33]); o.y = pk2(s[2 * 33], s[3 * 33]); o.z = pk2(s[4 * 33], s[5 * 33]); o.w = pk2(s[6 * 33], s[7 * 33]);
        *(v4u*)(WT + (size_t)(ndst0 + n) * lddst + kdst0 + 8 * c) = o; }
    LDS_WAIT(); asm volatile("" ::: "memory");
}
__device__ __forceinline__ unsigned pk4_fp8(float a, float b, float c, float d);

__device__ __forceinline__ void p0_transpose_item8(const float* W, int ldsrc, int ksrc0, int nsrc0, unsigned char* WT, int lddst, int ndst0, int kdst0, LAS float* scr, int lane) {
#pragma unroll 8
    for (int i = 0; i < 32; ++i) { const int kk = 2 * i + (lane >> 5); scr[kk * 33 + (lane & 31)] = W[(size_t)(ksrc0 + kk) * ldsrc + nsrc0 + (lane & 31)]; }
    LDS_WAIT(); asm volatile("" ::: "memory");
    const int c = lane & 3;
#pragma unroll
    for (int j = 0; j < 2; ++j) { const int n = (lane >> 2) + 16 * j; const LAS float* sp = scr + (16 * c) * 33 + n;
        v4u o; o.x = pk4_fp8(sp[0 * 33] * 32.f, sp[1 * 33] * 32.f, sp[2 * 33] * 32.f, sp[3 * 33] * 32.f); o.y = pk4_fp8(sp[4 * 33] * 32.f, sp[5 * 33] * 32.f, sp[6 * 33] * 32.f, sp[7 * 33] * 32.f);
        o.z = pk4_fp8(sp[8 * 33] * 32.f, sp[9 * 33] * 32.f, sp[10 * 33] * 32.f, sp[11 * 33] * 32.f); o.w = pk4_fp8(sp[12 * 33] * 32.f, sp[13 * 33] * 32.f, sp[14 * 33] * 32.f, sp[15 * 33] * 32.f);
        *(v4u*)(WT + (size_t)(ndst0 + n) * lddst + kdst0 + 16 * c) = o; }
    LDS_WAIT(); asm volatile("" ::: "memory");
}
struct TItem { const float* W; unsigned char* WT; int ldsrc, ksrc0, nsrc0, lddst, ndst0, kdst0, f8; };
__device__ __forceinline__ TItem p0_decode(const Args& a, int it) {
    unsigned char* ws = a.ws; TItem t;
    constexpr int I_IN = 8 * (NPROJ / 64), I_OUT = 16 * 16, I_GU = 8 * 32, I_DN = 8 * 16;
    int r = it;
    if (r < I_IN) { const int kb = r / (NPROJ / 64), nb = r % (NPROJ / 64), nd = 64 * nb;
        int ns = nd < DT_COL0 ? nd : nd + 16;
        if (nd >= 3584) { const int tt = (nd - 3584) >> 8, cc = (nd - 3584) & 255; ns = 16 + (cc < 128 ? 3584 + 128 * tt + cc : 4608 + 128 * tt + (cc - 128)); }
        t = TItem{a.in[I_WIN], ws + WS_WIN, PROJ_DIM, 128 * kb, ns, WIN_LD * 2, nd, 128 * kb * 2, 0}; return t; }
    r -= I_IN;
    if (r < I_OUT) { const int kb = r / 16, nb = r % 16, kd = 128 * kb, ks = (kd + 1024) & 2047;
        t = TItem{a.in[I_WOUT], ws + WS_WOUT, D, ks, 64 * nb, WOUT_LD * 2, 64 * nb, kd * 2, 0}; return t; }
    r -= I_OUT;
    if (r < NE * I_GU) { const int e = r / I_GU, q = r % I_GU, kb = q / 32, nb = q % 32, nd = 64 * nb;
        const int pn = nd >> 8, bj = (nd >> 7) & 1, cc = nd & 127, ns = bj * 1024 + 128 * pn + cc;
        t = TItem{a.in[I_WGU] + (size_t)e * D * 2048, ws + WS_WGU + (size_t)e * 2048 * D, 2048, 128 * kb, ns, D, nd, 128 * kb, 1}; return t; }
    r -= NE * I_GU;
    { const int e = r / I_DN, q = r % I_DN, kb = q / 16, nb = q % 16;
        t = TItem{a.in[I_WD] + (size_t)e * FF * D, ws + WS_WD + (size_t)e * D * FF, D, 128 * kb, 64 * nb, FF, 64 * nb, 128 * kb, 1}; return t; }
}
constexpr int P0_ITEMS_PROJ = 8 * (NPROJ / 64) + 16 * 16;
template <bool MOE>
__device__ __forceinline__ void p0_weights(const Args& a, LAS unsigned char* lds, int gw, int NGW, int wave) {
    const int lane = lane_id_v(), c = lane & 15, h = lane >> 4;
    LAS unsigned char* scr = lds + wave * 16384;
    constexpr int NITEMS = 8 * (NPROJ / 64) + 16 * 16 + NE * 8 * 32 + NE * 8 * 16;
    __syncthreads();
    for (int it = (MOE ? P0_ITEMS_PROJ : 0) + gw; it < (MOE ? NITEMS : P0_ITEMS_PROJ); it += NGW) {
        const TItem t = p0_decode(a, it);
        const float* src = t.W + (size_t)(t.ksrc0 + 4 * h) * t.ldsrc + t.nsrc0 + 4 * c;
        f32x4 v[32];
#pragma unroll
        for (int g = 0; g < 8; ++g)
#pragma unroll
            for (int r = 0; r < 4; ++r) v[4 * g + r] = *(const f32x4*)(src + (size_t)(16 * g + r) * t.ldsrc);
        if (t.f8) {
#pragma unroll
            for (int g = 0; g < 8; ++g)
#pragma unroll
                for (int j = 0; j < 4; ++j)
                    *(LAS unsigned*)(scr + (4 * c + j) * 144 + 16 * g + 4 * h) = pk4_fp8(v[4 * g][j] * 32.f, v[4 * g + 1][j] * 32.f, v[4 * g + 2][j] * 32.f, v[4 * g + 3][j] * 32.f);
            LDS_WAIT(); asm volatile("" ::: "memory");
#pragma unroll
            for (int q = 0; q < 8; ++q) { const int n = 8 * q + (lane >> 3), ch = lane & 7;
                *(v4u*)(t.WT + (size_t)(t.ndst0 + n) * t.lddst + t.kdst0 + 16 * ch) = *(const LAS v4u*)(scr + n * 144 + 16 * ch); }
        } else {
#pragma unroll
            for (int g = 0; g < 8; ++g)
#pragma unroll
                for (int j = 0; j < 4; ++j) { v2u w; w.x = pk2(v[4 * g][j], v[4 * g + 1][j]); w.y = pk2(v[4 * g + 2][j], v[4 * g + 3][j]);
                    *(LAS v2u*)(scr + (4 * c + j) * 256 + 32 * g + 8 * h) = w; }
            LDS_WAIT(); asm volatile("" ::: "memory");
#pragma unroll
            for (int q = 0; q < 16; ++q) { const int n = 4 * q + (lane >> 4), ch = lane & 15;
                *(v4u*)(t.WT + (size_t)(t.ndst0 + n) * t.lddst + t.kdst0 + 16 * ch) = *(const LAS v4u*)(scr + n * 256 + 16 * ch); }
        }
        LDS_WAIT(); asm volatile("" ::: "memory");
    }
}
__device__ __forceinline__ void rms_row_to_bf16(const float* xrow, const float* w, bf16* orow, int lane) {
    const f32x4* xr = (const f32x4*)xrow + lane; const f32x4* wr = (const f32x4*)w + lane;
    f32x4 v[4]; float s = 0.f;
#pragma unroll
    for (int j = 0; j < 4; ++j) { v[j] = xr[64 * j]; s += (v[j].x * v[j].x + v[j].y * v[j].y) + (v[j].z * v[j].z + v[j].w * v[j].w); }
    const float rinv = 1.0f / sqrtf(wave_sum(s) * (1.f / D) + EPS);
    v2u* o8 = (v2u*)orow + lane;
#pragma unroll
    for (int j = 0; j < 4; ++j) { const f32x4 ww = wr[64 * j]; v2u o; o.x = pk2(v[j].x * rinv * ww.x, v[j].y * rinv * ww.y); o.y = pk2(v[j].z * rinv * ww.z, v[j].w * rinv * ww.w); o8[64 * j] = o; }
}
__device__ __forceinline__ void p0_dt_slow(const Args& a, int wg, int G) {
    const int tid = threadIdx.x, rl = tid >> 4, hd = tid & 15;
    const float* x = a.in[I_X]; const float* nw = a.in[I_N1W]; const float* win = a.in[I_WIN] + DT_COL0 + hd;
    float* dt = (float*)(a.ws + WS_DT);
    for (int r0 = wg * 32; r0 < T; r0 += G * 32) {
        const int row = r0 + rl; const float* xr = x + (size_t)row * D;
        float s = 0.f, d = 0.f;
        for (int k = 0; k < D; ++k) { const float xv = xr[k]; s += xv * xv; d += xv * nw[k] * win[(size_t)k * PROJ_DIM]; }
        const float rinv = 1.0f / sqrtf(s * (1.f / D) + EPS);
        dt[row * 16 + hd] = softplus_f(d * rinv + a.in[I_DTB][hd]);
    }
}

constexpr int SG_LD = 132;
template <class ARow>
__device__ __forceinline__ void sg_tile(LAS float* As, LAS float* Bs, const ARow& arow, const bf16* Bt, int ldb, int K, float (&acc)[8][4]) {
    const int t = threadIdx.x, tm = t >> 5, tn = t & 31, lr = t >> 2, kq = t & 3;
    const bf16* ap = arow(lr) + 8 * kq;
    const bf16* bp = Bt + (size_t)lr * ldb + 8 * kq;
#pragma unroll
    for (int i = 0; i < 8; ++i)
#pragma unroll
        for (int j = 0; j < 4; ++j) acc[i][j] = 0.f;
    for (int k0 = 0; k0 < K; k0 += 32) {
        const v4u av = *(const v4u*)(ap + k0), bv = *(const v4u*)(bp + k0);
        __syncthreads();
        { LAS float* pa = As + (8 * kq) * SG_LD + lr; LAS float* pb = Bs + (8 * kq) * SG_LD + lr;
          pa[0 * SG_LD] = bflo(av.x); pa[1 * SG_LD] = bfhi(av.x); pa[2 * SG_LD] = bflo(av.y); pa[3 * SG_LD] = bfhi(av.y);
          pa[4 * SG_LD] = bflo(av.z); pa[5 * SG_LD] = bfhi(av.z); pa[6 * SG_LD] = bflo(av.w); pa[7 * SG_LD] = bfhi(av.w);
          pb[0 * SG_LD] = bflo(bv.x); pb[1 * SG_LD] = bfhi(bv.x); pb[2 * SG_LD] = bflo(bv.y); pb[3 * SG_LD] = bfhi(bv.y);
          pb[4 * SG_LD] = bflo(bv.z); pb[5 * SG_LD] = bfhi(bv.z); pb[6 * SG_LD] = bflo(bv.w); pb[7 * SG_LD] = bfhi(bv.w); }
        __syncthreads();
#pragma unroll 8
        for (int kk = 0; kk < 32; ++kk) {
            const f32x4 a0 = *(const LAS f32x4*)(As + kk * SG_LD + 8 * tm), a1 = *(const LAS f32x4*)(As + kk * SG_LD + 8 * tm + 4);
            const f32x4 b = *(const LAS f32x4*)(Bs + kk * SG_LD + 4 * tn);
            const float av8[8] = {a0.x, a0.y, a0.z, a0.w, a1.x, a1.y, a1.z, a1.w};
#pragma unroll
            for (int i = 0; i < 8; ++i) { acc[i][0] += av8[i] * b.x; acc[i][1] += av8[i] * b.y; acc[i][2] += av8[i] * b.z; acc[i][3] += av8[i] * b.w; }
        }
    }
    __syncthreads();
}

namespace pg8 {
constexpr int BM = 256, BK = 64, HALF = 128, HTB = HALF * BK * 2, STAGE_BYTES = 8 * HTB;
__device__ __forceinline__ int lds_byte(int r, int c) { const int st = (r >> 4) * 2 + (c >> 5), rr = r & 15, cc = c & 31, ob = rr * 64 + cc * 2; return st * 1024 + (ob ^ (((ob >> 9) & 1) << 5)); }
__device__ __forceinline__ void stage_rc(int b, int& R, int& C) { const int st = b / 1024, sb = b % 1024, swz = sb ^ (((sb >> 9) & 1) << 5); R = (st >> 1) * 16 + swz / 64; C = (st & 1) * 32 + (swz % 64) / 2; }
__device__ __forceinline__ int perm32(int rho) { const int n = rho >> 4, i = rho & 15; return 8 * (i >> 2) + 4 * n + (i & 3); }
struct Unit { int pm, pn, aux; };
typedef int v8i __attribute__((ext_vector_type(8)));
typedef int v4i __attribute__((ext_vector_type(4)));
template <class Epi, class Sched, bool ALIGN_EPI, bool F8 = false>
__device__ __forceinline__ void gemm_phase(LAS unsigned char* lds, const char* Abase, const int K, const Sched& S, const Epi& E, const int wid) {
    const int lane = lane_id(), tid = wid * 64 + lane, wr = wid >> 2, wc = wid & 3, fr = lane & 15, fq = lane >> 4;
    const int nt = K / BK;
    unsigned voffB[2];
#pragma unroll
    for (int i = 0; i < 2; ++i) { int R_, C_; stage_rc(tid * 16 + i * 8192, R_, C_); const int Rb = Epi::PERM ? ((R_ & ~31) + perm32(R_ & 31)) : R_; voffB[i] = (unsigned)Rb * S.ldbB + (unsigned)C_ * 2u; }
    const size_t kstep = (size_t)(BK * 2), hstepB = (size_t)HALF * S.ldbB;
    const unsigned ldsw = (unsigned)wid * 1024u;
    const int aoff = lds_byte(wr * 64 + fr, fq * 8), boff = lds_byte(wc * 32 + fr, fq * 8);
#define PG8_SA(b, h) (((b) * 2 + (h)) * HTB)
#define PG8_SB(b, h) ((4 + (b) * 2 + (h)) * HTB)
#define PG8_STAGE(bufoff, gbase, voff) do { _Pragma("unroll") for (int _i = 0; _i < 2; ++_i) \
        __builtin_amdgcn_global_load_lds((const unsigned*)((const char*)(gbase) + (voff)[_i]), (LAS unsigned*)(lds + (bufoff) + ldsw + _i * 8192), 16, 0, 0); } while (0)
#define PG8_LDA(dst, b, h) do { _Pragma("unroll") for (int m = 0; m < 4; ++m) { if constexpr (F8) { dst##8[m].lo = *(const LAS v4i*)(lds + PG8_SA(b, h) + aoff + m * 2048); dst##8[m].hi = *(const LAS v4i*)(lds + PG8_SA(b, h) + aoff + m * 2048 + 1024); } \
        else { _Pragma("unroll") for (int k = 0; k < 2; ++k) dst[m][k] = *(const LAS bf16x8*)(lds + PG8_SA(b, h) + aoff + m * 2048 + k * 1024); } } } while (0)
#define PG8_LDB(dst, b, h) do { _Pragma("unroll") for (int n = 0; n < 2; ++n) { if constexpr (F8) { dst##8[n].lo = *(const LAS v4i*)(lds + PG8_SB(b, h) + boff + n * 2048); dst##8[n].hi = *(const LAS v4i*)(lds + PG8_SB(b, h) + boff + n * 2048 + 1024); } \
        else { _Pragma("unroll") for (int k = 0; k < 2; ++k) dst[n][k] = *(const LAS bf16x8*)(lds + PG8_SB(b, h) + boff + n * 2048 + k * 1024); } } } while (0)
#define PG8_MMA(ai, bj, At, Bt) do { __builtin_amdgcn_s_setprio(1); _Pragma("unroll") for (int m = 0; m < 4; ++m) _Pragma("unroll") for (int n = 0; n < 2; ++n) { \
        if constexpr (F8) asm volatile("v_mfma_scale_f32_16x16x128_f8f6f4 %0, %1, %2, %0, %3, %3 op_sel_hi:[0,0,0]" : "+v"(acc[ai][bj][m][n]) : "v"(Bt##8[n]), "v"(At##8[m]), "v"(one_scale));   \
        else { _Pragma("unroll") for (int k = 0; k < 2; ++k) acc[ai][bj][m][n] = __builtin_amdgcn_mfma_f32_16x16x32_bf16(Bt[n][k], At[m][k], acc[ai][bj][m][n], 0, 0, 0); } } \
        __builtin_amdgcn_s_setprio(0); } while (0)
#define PG8_WAIT_V(n) asm volatile("s_waitcnt vmcnt(" #n ")" ::: "memory")
#define PG8_WAIT_L(n) asm volatile("s_waitcnt lgkmcnt(" #n ")" ::: "memory")
#define PG8_WAIT_V8S do { if (post_epi) asm volatile("s_waitcnt vmcnt(%0)" :: "n"(8 + Epi::NST) : "memory"); else asm volatile("s_waitcnt vmcnt(8)" ::: "memory"); } while (0)
#define PG8_BAR __builtin_amdgcn_s_barrier()
#define PG8_SCHED __builtin_amdgcn_sched_barrier(0)
    Unit cur, nxt; int ui = 0;
    if (!S.next(0, cur)) return;
    f32x4 acc[2][2][4][2];
#pragma unroll
    for (int a = 0; a < 2; ++a)
#pragma unroll
        for (int b = 0; b < 2; ++b)
#pragma unroll
            for (int m = 0; m < 4; ++m)
#pragma unroll
                for (int n = 0; n < 2; ++n) acc[a][b][m][n] = (f32x4){0.f, 0.f, 0.f, 0.f};
    bf16x8 At[4][2], B0[2][2], B1[2][2]; v8i At8[4], B08[2], B18[2]; const int one_scale = 0x7f7f7f7f;
    unsigned cA0[2], cA1[2], nA0[2], nA1[2];
    S.a_offs(cur, tid, cA0, cA1);
    const char* cB = S.b_base(cur);
    PG8_STAGE(PG8_SB(0, 0), cB, voffB); PG8_STAGE(PG8_SB(0, 1), cB + hstepB, voffB); PG8_STAGE(PG8_SA(0, 0), Abase, cA0); PG8_STAGE(PG8_SA(0, 1), Abase, cA1);
    if (wr == 1) PG8_BAR;
    PG8_WAIT_V(2); PG8_BAR;
    PG8_STAGE(PG8_SB(1, 0), cB + kstep, voffB); PG8_STAGE(PG8_SA(1, 0), Abase + kstep, cA0); PG8_STAGE(PG8_SB(1, 1), cB + hstepB + kstep, voffB);
    PG8_WAIT_V(6); PG8_BAR;
    for (;;) {
        const bool has_next = S.next(ui + 1, nxt);
        const char* nB = cB;
        if (has_next) { S.a_offs(nxt, tid, nA0, nA1); nB = S.b_base(nxt); } else { nA0[0] = cA0[0]; nA0[1] = cA0[1]; nA1[0] = cA1[0]; nA1[1] = cA1[1]; }
#pragma unroll 1
        for (int t = 0; t < nt; t += 2) {
            const bool last = (t == nt - 2);
            const bool post_epi = (t == 0) && (ui > 0);
            if (last) E.dma(cur, lds + 135168, wid, tid & 63);
            const char* a1 = Abase + (size_t)(t + 1) * kstep;
            const char* a2 = last ? Abase : Abase + (size_t)(t + 2) * kstep; const char* b2 = last ? nB : cB + (size_t)(t + 2) * kstep;
            const char* a3 = a2 + kstep; const char* b3 = b2 + kstep;
            unsigned x0[2], x1[2];
            x0[0] = last ? nA0[0] : cA0[0]; x0[1] = last ? nA0[1] : cA0[1]; x1[0] = last ? nA1[0] : cA1[0]; x1[1] = last ? nA1[1] : cA1[1];
            PG8_LDB(B0, 0, 0); PG8_LDB(B1, 0, 1); PG8_SCHED; PG8_LDA(At, 0, 0); PG8_STAGE(PG8_SA(1, 1), a1, cA1);
            PG8_WAIT_V8S; PG8_BAR; PG8_MMA(0, 0, At, B0); PG8_MMA(0, 1, At, B1); PG8_BAR; PG8_SCHED;
            PG8_LDA(At, 0, 1); PG8_STAGE(PG8_SB(0, 0), b2, voffB); PG8_STAGE(PG8_SB(0, 1), b2 + hstepB, voffB); PG8_STAGE(PG8_SA(0, 0), a2, x0);
            PG8_WAIT_V8S; PG8_BAR; PG8_MMA(1, 0, At, B0); PG8_MMA(1, 1, At, B1); PG8_BAR; PG8_SCHED;
            PG8_LDB(B0, 1, 0); PG8_LDB(B1, 1, 1); PG8_SCHED; PG8_LDA(At, 1, 0); PG8_STAGE(PG8_SA(0, 1), a2, x1);
            PG8_WAIT_V(8); PG8_BAR; PG8_MMA(0, 0, At, B0); PG8_MMA(0, 1, At, B1); PG8_BAR; PG8_SCHED;
            PG8_LDA(At, 1, 1); PG8_STAGE(PG8_SB(1, 0), b3, voffB); PG8_STAGE(PG8_SB(1, 1), b3 + hstepB, voffB); PG8_STAGE(PG8_SA(1, 0), a3, x0);
            PG8_WAIT_V(8); PG8_BAR; PG8_MMA(1, 0, At, B0); PG8_MMA(1, 1, At, B1); PG8_BAR; PG8_SCHED;
        }
        if constexpr (ALIGN_EPI) { if (wr == 0) PG8_BAR; }
        if constexpr (F8) asm volatile("s_nop 15\n\ts_nop 15" ::: "memory");
        E(acc, cur, wr, wc, fr, fq, lds + 135168);
        if (!has_next) break;
#pragma unroll
        for (int a = 0; a < 2; ++a)
#pragma unroll
            for (int b = 0; b < 2; ++b)
#pragma unroll
                for (int m = 0; m < 4; ++m)
#pragma unroll
                    for (int n = 0; n < 2; ++n) acc[a][b][m][n] = (f32x4){0.f, 0.f, 0.f, 0.f};
        cur = nxt; cB = nB; cA0[0] = nA0[0]; cA0[1] = nA0[1]; cA1[0] = nA1[0]; cA1[1] = nA1[1]; ++ui;
        if constexpr (ALIGN_EPI) { if (wr == 1) PG8_BAR; }
    }
    PG8_WAIT_V(0);
    if constexpr (!ALIGN_EPI) { if (wr == 0) PG8_BAR; }
    PG8_BAR;
#undef PG8_SA
#undef PG8_SB
#undef PG8_STAGE
#undef PG8_LDA
#undef PG8_LDB
#undef PG8_MMA
#undef PG8_WAIT_V
#undef PG8_WAIT_L
#undef PG8_WAIT_V8S
#undef PG8_BAR
#undef PG8_SCHED
}
__device__ __forceinline__ unsigned cvt_pk_bf16(float lo, float hi) { unsigned r; asm volatile("v_cvt_pk_bf16_f32 %0, %1, %2" : "=v"(r) : "v"(lo), "v"(hi)); return r; }

struct DenseSched {
    int nM, nN, nwg, G, c, GS = 8; bool rev = false; unsigned lda2, ldbB;
    __device__ __forceinline__ void init(int M, int N, int G_, int c_, int lda) { nM = M / BM; nN = N / BM; nwg = nM * nN; G = G_; c = c_; lda2 = (unsigned)lda * 2u; }
    __device__ __forceinline__ bool next(int i, Unit& u) const {
        const long L = (long)i * G + c; if (L >= nwg) return false;
        int wgid = (int)L; { const int q = nwg / 8, r = nwg % 8, xcd = wgid % 8, off = wgid / 8; wgid = (xcd < r ? xcd * (q + 1) : r * (q + 1) + (xcd - r) * q) + off; }
        if (rev) wgid = nwg - 1 - wgid;
        const int nig = GS * nN, gid = wgid / nig, fm = gid * GS, gsz = (nM - fm) < GS ? (nM - fm) : GS;
        u.pm = fm + ((wgid % nig) % gsz); u.pn = (wgid % nig) / gsz; u.aux = 0; return true;
    }
    const char* Bt; size_t tstepB;
    __device__ __forceinline__ void a_offs(const Unit& u, int tid, unsigned (&o0)[2], unsigned (&o1)[2]) const {
        int R[2], C[2]; stage_rc(tid * 16, R[0], C[0]); stage_rc(tid * 16 + 8192, R[1], C[1]);
#pragma unroll
        for (int i = 0; i < 2; ++i) { o0[i] = (unsigned)(u.pm * BM + R[i]) * lda2 + (unsigned)C[i] * 2u; o1[i] = o0[i] + 128u * lda2; }
    }
    __device__ __forceinline__ const char* b_base(const Unit& u) const { return Bt + (size_t)u.pn * tstepB; }
};
}

__device__ __forceinline__ bf16* proj_ptr(unsigned char* ws, int row, int n) {
    if (n < 1024) return (bf16*)(ws + WS_Z) + (size_t)row * 1024 + n;
    if (n < 2560) return (bf16*)(ws + WS_XBC) + (size_t)row * DXBC + (n - 1024);
    if (n < 4608) return (bf16*)(ws + WS_G2) + (size_t)row * 2048 + (n - 2560);
    return (bf16*)(ws + WS_U) + (size_t)row * 1024 + (n - 4608);
}
__device__ __forceinline__ void p1_slow(const Args& a, LAS unsigned char* lds, int wg, int G) {
    LAS float* As = (LAS float*)lds; LAS float* Bs = As + 32 * SG_LD;
    const bf16* xn = (const bf16*)((unsigned char*)a.out + DO_XN); const bf16* wt = (const bf16*)(a.ws + WS_WIN);
    const int t = threadIdx.x, tm = t >> 5, tn = t & 31;
    for (int it = wg; it < (T / 128) * (NPROJ / 128); it += G) {
        const int mt = it / (NPROJ / 128), nt = it % (NPROJ / 128);
        float acc[8][4];
        auto arow = [&](int r) { return xn + (size_t)(mt * 128 + r) * D; };
        sg_tile(As, Bs, arow, wt + (size_t)nt * 128 * D, D, D, acc);
#pragma unroll
        for (int i = 0; i < 8; ++i) { v2u o; o.x = pk2(acc[i][0], acc[i][1]); o.y = pk2(acc[i][2], acc[i][3]);
            *(v2u*)proj_ptr(a.ws, mt * 128 + 8 * tm + i, nt * 128 + 4 * tn) = o; }
    }
}

__device__ __forceinline__ void ssd_conv_slow(const Args& a, int wg, int G) {
    const bf16* xbc = (const bf16*)(a.ws + WS_XBC); bf16* xc = (bf16*)((unsigned char*)a.out + DO_XC);
    const float* cw = a.in[I_SCW]; const float* cb = a.in[I_SCB];
    for (size_t i = (size_t)wg * NTHREADS + threadIdx.x; i < (size_t)T * (DXBC / 4); i += (size_t)G * NTHREADS) {
        const int row = (int)(i / (DXBC / 4)), c = 4 * (int)(i % (DXBC / 4)), tl = row % SEQ;
        float s[4] = {cb[c], cb[c + 1], cb[c + 2], cb[c + 3]};
#pragma unroll
        for (int k = 0; k < 4; ++k) { const int tt = tl - 3 + k; if (tt < 0) continue;
            const v2u v = *(const v2u*)(xbc + (size_t)(row - 3 + k) * DXBC + c);
            s[0] += cw[k * DXBC + c] * bflo(v.x); s[1] += cw[k * DXBC + c + 1] * bfhi(v.x); s[2] += cw[k * DXBC + c + 2] * bflo(v.y); s[3] += cw[k * DXBC + c + 3] * bfhi(v.y); }
        v2u o; o.x = pk2(silu_f(s[0]), silu_f(s[1])); o.y = pk2(silu_f(s[2]), silu_f(s[3]));
        *(v2u*)(xc + (size_t)row * DXBC + c) = o;
    }
}
__device__ __forceinline__ void ssd_rec_slow(const Args& a, LAS unsigned char* lds, int wg) {
    if (wg >= NBATCH * NH) return;
    const int b = wg >> 4, h = wg & 15, g = h >> 3, tid = threadIdx.x, lane = tid & 63;
    const bf16* xc = (const bf16*)((unsigned char*)a.out + DO_XC); const float* dt = (const float*)(a.ws + WS_DT);
    bf16* g2 = (bf16*)(a.ws + WS_G2);
    LAS float* Bc = (LAS float*)lds; LAS float* Cc = Bc + 64 * 128;
    const float A = -expf(a.in[I_ALOG][h]), Dh = a.in[I_DSKIP][h];
    float st[128];
#pragma unroll
    for (int n = 0; n < 128; ++n) st[n] = 0.f;
    for (int t0 = 0; t0 < SEQ; t0 += 64) {
        __syncthreads();
        { const int tt = tid >> 3, seg = tid & 7; const size_t row = (size_t)b * SEQ + t0 + tt;
          const bf16* pb = xc + row * DXBC + 1024 + 128 * g + 16 * seg; const bf16* pc = xc + row * DXBC + 1280 + 128 * g + 16 * seg;
#pragma unroll
          for (int q = 0; q < 2; ++q) { const v4u vb = *(const v4u*)(pb + 8 * q), vc = *(const v4u*)(pc + 8 * q);
              LAS float* ob = Bc + tt * 128 + 16 * seg + 8 * q; LAS float* oc = Cc + tt * 128 + 16 * seg + 8 * q;
              ob[0] = bflo(vb.x); ob[1] = bfhi(vb.x); ob[2] = bflo(vb.y); ob[3] = bfhi(vb.y); ob[4] = bflo(vb.z); ob[5] = bfhi(vb.z); ob[6] = bflo(vb.w); ob[7] = bfhi(vb.w);
              oc[0] = bflo(vc.x); oc[1] = bfhi(vc.x); oc[2] = bflo(vc.y); oc[3] = bfhi(vc.y); oc[4] = bflo(vc.z); oc[5] = bfhi(vc.z); oc[6] = bflo(vc.w); oc[7] = bfhi(vc.w); } }
        __syncthreads();
        if (tid < 64) {
            for (int tt = 0; tt < 64; ++tt) {
                const size_t row = (size_t)b * SEQ + t0 + tt;
                const float dtv = dt[row * 16 + h], x = bf2f(xc[row * DXBC + h * 64 + lane]);
                const float dec = expf(dtv * A), xd = dtv * x; float y = 0.f;
#pragma unroll
                for (int n4 = 0; n4 < 32; ++n4) { const f32x4 bv = *(const LAS f32x4*)(Bc + tt * 128 + 4 * n4), cv = *(const LAS f32x4*)(Cc + tt * 128 + 4 * n4);
                    st[4 * n4 + 0] = st[4 * n4 + 0] * dec + xd * bv.x; y += st[4 * n4 + 0] * cv.x;
                    st[4 * n4 + 1] = st[4 * n4 + 1] * dec + xd * bv.y; y += st[4 * n4 + 1] * cv.y;
                    st[4 * n4 + 2] = st[4 * n4 + 2] * dec + xd * bv.z; y += st[4 * n4 + 2] * cv.z;
                    st[4 * n4 + 3] = st[4 * n4 + 3] * dec + xd * bv.w; y += st[4 * n4 + 3] * cv.w; }
                y += Dh * x;
                g2[row * 2048 + 1024 + h * 64 + lane] = (bf16)f2bf(y);
            }
        }
    }
}
__device__ __forceinline__ void ssd_norm_slow(const Args& a, int gw, int NGW, int lane) {
    bf16* g2 = (bf16*)(a.ws + WS_G2); const bf16* z = (const bf16*)(a.ws + WS_Z); const float* nw = a.in[I_SNW];
    for (int it = gw; it < T * NG; it += NGW) {
        const int row = it >> 1, g = it & 1, ch = 512 * g + 8 * lane;
        bf16* yp = g2 + (size_t)row * 2048 + 1024 + ch;
        const v4u yv = *(const v4u*)yp, zv = *(const v4u*)(z + (size_t)row * 1024 + ch);
        float gg[8]; const unsigned yw[4] = {yv.x, yv.y, yv.z, yv.w}, zw[4] = {zv.x, zv.y, zv.z, zv.w}; float ss = 0.f;
#pragma unroll
        for (int j = 0; j < 4; ++j) { gg[2 * j] = bflo(yw[j]) * silu_f(bflo(zw[j])); gg[2 * j + 1] = bfhi(yw[j]) * silu_f(bfhi(zw[j])); ss += gg[2 * j] * gg[2 * j] + gg[2 * j + 1] * gg[2 * j + 1]; }
        const float rinv = 1.0f / sqrtf(wave_sum(ss) * (1.f / 512.f) + EPS);
        v4u o; o.x = pk2(gg[0] * rinv * nw[ch], gg[1] * rinv * nw[ch + 1]); o.y = pk2(gg[2] * rinv * nw[ch + 2], gg[3] * rinv * nw[ch + 3]);
        o.z = pk2(gg[4] * rinv * nw[ch + 4], gg[5] * rinv * nw[ch + 5]); o.w = pk2(gg[6] * rinv * nw[ch + 6], gg[7] * rinv * nw[ch + 7]);
        *(v4u*)yp = o;
    }
}


constexpr int SS_ACUM = 0, SS_E2 = 4096, SS_EI = 8192, SS_R = 12288, SS_SSUM = 12416, SS_C = 16896, SS_CB = 51712, SS_X = 86528;
constexpr int SS_LD = 272, SS_XLD = 144;
static_assert(SS_X + 512 * SS_XLD <= LDS_BYTES - 64 && SS_C + 128 * SS_LD <= SS_CB && SS_CB + 128 * SS_LD <= SS_X, "SSD LDS map");
typedef float f32x4v __attribute__((ext_vector_type(4)));
__device__ __forceinline__ void unpack8(const v4u v, float* f);
__device__ __forceinline__ float wave_incl_scan(float v, int lane) {
#pragma unroll
    for (int o = 1; o < 64; o <<= 1) { const float t = bperm(v, lane >= o ? lane - o : lane); if (lane >= o) v += t; }
    return v;
}
template <int MODE>
__device__ __forceinline__ void ssd_tables(const Args& a, LAS unsigned char* lds, int b, int c, int g, int wave, int lane) {
    const float* dt = (const float*)(a.ws + WS_DT); const int h = 8 * g + wave; const float A = -expf(a.in[I_ALOG][h]);
    const size_t row0 = (size_t)b * SEQ + (size_t)c * CHK;
    const float d0 = dt[(row0 + 2 * lane) * 16 + h], d1 = dt[(row0 + 2 * lane + 1) * 16 + h];
    const float s1 = (d0 + d1) * A, incl = wave_incl_scan(s1, lane), ex = incl - s1;
    const float a0 = ex + d0 * A, a1 = incl, tot = bperm(incl, lane | 63);
    LAS float* acum = (LAS float*)(lds + SS_ACUM) + wave * 128; LAS float* e2 = (LAS float*)(lds + SS_E2) + wave * 128; LAS float* ei = (LAS float*)(lds + SS_EI) + wave * 128;
    acum[2 * lane] = a0; acum[2 * lane + 1] = a1;
    if (MODE == 0) { e2[2 * lane] = d0 * __expf(tot - a0); e2[2 * lane + 1] = d1 * __expf(tot - a1);
        if (lane == 0) ((float*)(a.ws + WS_CDEC))[((size_t)b * NCHK + c) * NH + h] = __expf(tot); }
    else {
        const float Rb = bperm(ex, lane & 48);
        e2[2 * lane] = d0 * __expf(fminf(Rb - a0, 80.f)); e2[2 * lane + 1] = d1 * __expf(fminf(Rb - a1, 80.f));
        ei[2 * lane] = __expf(a0); ei[2 * lane + 1] = __expf(a1);
        if ((lane & 15) == 0) ((LAS float*)(lds + SS_R))[wave * 4 + (lane >> 4)] = Rb; }
}
template <bool TRANS, bool SCALE>
__device__ __forceinline__ void conv_stage(const Args& a, LAS unsigned char* dst, int strideB, int b, int c, int col0, int nq, int t0, int ntb, const LAS float* scale, int wave) {
    const bf16* xbc = (const bf16*)(a.ws + WS_XBC); const float* cw = a.in[I_SCW]; const float* cb = a.in[I_SCB];
    const int tid_ = wave * 64 + lane_id_v();
    const int qd = tid_ % nq, ch = col0 + 4 * qd;
    const f32x4 w0 = *(const f32x4*)(cw + ch), w1 = *(const f32x4*)(cw + DXBC + ch), w2 = *(const f32x4*)(cw + 2 * DXBC + ch), w3 = *(const f32x4*)(cw + 3 * DXBC + ch), bs = *(const f32x4*)(cb + ch);
    for (int tb = tid_ / nq; tb < ntb; tb += NTHREADS / nq) {
        const int tl = t0 + 8 * tb, tab0 = c * CHK + tl;
        const bf16* src = xbc + ((size_t)b * SEQ + tab0) * DXBC + ch;
        v2u pin[11];
#pragma unroll
        for (int r = 0; r < 11; ++r) pin[r] = *(const v2u*)(src + (ptrdiff_t)((c > 0 || tl + r >= 3) ? r - 3 : 0) * DXBC);
        if (c == 0) {
#pragma unroll
            for (int r = 0; r < 3; ++r) if (tl + r < 3) pin[r] = (v2u){0u, 0u}; }
        if (TRANS) {
#pragma unroll
            for (int q = 0; q < 4; ++q) {
                float x[11];
#pragma unroll
                for (int r = 0; r < 11; ++r) { const unsigned wd = (q < 2) ? pin[r].x : pin[r].y; x[r] = (q & 1) ? bfhi(wd) : bflo(wd); }
                float o[8];
#pragma unroll
                for (int tt = 0; tt < 8; ++tt) { float v = bs[q] + w0[q] * x[tt] + w1[q] * x[tt + 1] + w2[q] * x[tt + 2] + w3[q] * x[tt + 3]; v = silu_fast(v); if (SCALE) v *= scale[((ch - col0) >> 6) * 128 + tl + tt]; o[tt] = v; }
                v4u w; w.x = pk2_hw(o[0], o[1]); w.y = pk2_hw(o[2], o[3]); w.z = pk2_hw(o[4], o[5]); w.w = pk2_hw(o[6], o[7]);
                *(LAS v4u*)(dst + (ch - col0 + q) * strideB + (tl - t0) * 2) = w; }
        } else {
#pragma unroll
            for (int tt = 0; tt < 8; ++tt) { float o[4];
#pragma unroll
                for (int q = 0; q < 4; ++q) { float xx[4];
#pragma unroll
                    for (int k = 0; k < 4; ++k) { const unsigned wd = (q < 2) ? pin[tt + k].x : pin[tt + k].y; xx[k] = (q & 1) ? bfhi(wd) : bflo(wd); }
                    o[q] = silu_fast(bs[q] + w0[q] * xx[0] + w1[q] * xx[1] + w2[q] * xx[2] + w3[q] * xx[3]); }
                v2u w; w.x = pk2_hw(o[0], o[1]); w.y = pk2_hw(o[2], o[3]); *(LAS v2u*)(dst + (tl - t0 + tt) * strideB + (ch - col0) * 2) = w; }
        }
    }
}
#define MFMA16(A_, B_, C_) __builtin_amdgcn_mfma_f32_16x16x32_bf16((A_), (B_), (C_), 0, 0, 0)
__device__ __forceinline__ void ssd_state_phase(const Args& a, LAS unsigned char* lds, int wg, int G, int wave) {
    bf16* S = (bf16*)((unsigned char*)a.out + DO_S);
    for (int u = wg; u < NBATCH * NCHK * NG; u += G) {
        const int g = u & 1, c = (u >> 1) & (NCHK - 1), b = u >> 7;
        const int lane = lane_id_v(); const int r = lane & 15, q = lane >> 4;
        __syncthreads();
        ssd_tables<0>(a, lds, b, c, g, wave, lane);
        conv_stage<true, false>(a, lds + SS_C, SS_LD, b, c, 1024 + 128 * g, 32, 0, 16, nullptr, wave);
        __syncthreads();
        f32x4 acc[8][4];
#pragma unroll
        for (int nt = 0; nt < 8; ++nt)
#pragma unroll
            for (int pt = 0; pt < 4; ++pt) acc[nt][pt] = (f32x4){0.f, 0.f, 0.f, 0.f};
        LAS unsigned char* BT = lds + SS_C; LAS unsigned char* XT = lds + SS_X;
        for (int jh = 0; jh < 2; ++jh) {
            if (jh) __syncthreads();
            conv_stage<true, true>(a, XT, SS_XLD, b, c, 512 * g, 128, 64 * jh, 8, (const LAS float*)(lds + SS_E2), wave);
            __syncthreads();
#pragma unroll
            for (int kk = 0; kk < 2; ++kk) { const int ks = 2 * jh + kk;
                bf16x8 xb[4];
#pragma unroll
                for (int pt = 0; pt < 4; ++pt) xb[pt] = *(const LAS bf16x8*)(XT + (64 * wave + 16 * pt + r) * SS_XLD + (32 * kk + 8 * q) * 2);
#pragma unroll
                for (int nt = 0; nt < 8; ++nt) { const bf16x8 bt = *(const LAS bf16x8*)(BT + (64 * (nt >> 2) + 16 * (r >> 2) + 4 * (nt & 3) + (r & 3)) * SS_LD + (32 * ks + 8 * q) * 2);
#pragma unroll
                    for (int pt = 0; pt < 4; ++pt) acc[nt][pt] = MFMA16(bt, xb[pt], acc[nt][pt]); }
            }
        }
        bf16* Sp = S + ((((size_t)b * NCHK + c) * NH + 8 * g + wave) * 64) * 128;
#pragma unroll
        for (int G4 = 0; G4 < 2; ++G4)
#pragma unroll
            for (int pt = 0; pt < 4; ++pt) { const f32x4 a0 = acc[4 * G4][pt], a1 = acc[4 * G4 + 1][pt], a2 = acc[4 * G4 + 2][pt], a3 = acc[4 * G4 + 3][pt];
                v4u o0, o1; o0.x = pk2(a0[0], a0[1]); o0.y = pk2(a0[2], a0[3]); o0.z = pk2(a1[0], a1[1]); o0.w = pk2(a1[2], a1[3]);
                o1.x = pk2(a2[0], a2[1]); o1.y = pk2(a2[2], a2[3]); o1.z = pk2(a3[0], a3[1]); o1.w = pk2(a3[2], a3[3]);
                bf16* dp = Sp + (16 * pt + r) * 128 + 64 * G4 + 16 * q; *(v4u*)dp = o0; *(v4u*)(dp + 8) = o1; }
    }
}
__device__ __forceinline__ void ssd_scan_phase(const Args& a, int wg, int G, int wave) {
    bf16* S = (bf16*)((unsigned char*)a.out + DO_S); const float* cdec = (const float*)(a.ws + WS_CDEC);
    for (int gid0 = wg * NTHREADS + wave * 64; gid0 < NBATCH * NH * 1024; gid0 += G * NTHREADS) {
        const int gid = gid0 + lane_id_v();
        const int bh = __builtin_amdgcn_readfirstlane(gid0 >> 10), e8 = gid & 1023, b = bh >> 4, h = bh & 15;
        float st[8];
#pragma unroll
        for (int j = 0; j < 8; ++j) st[j] = 0.f;
        bf16* Sp = S + ((size_t)b * NCHK * NH + h) * 8192 + 8 * e8; const float* dcp = cdec + (size_t)b * NCHK * NH + h;
        v4u sa[16], sb[16];
#define SCAN_LOAD(arr, c) { _Pragma("unroll") for (int k_ = 0; k_ < 16; ++k_) arr[k_] = *(const v4u*)(Sp + (size_t)(16 * (c) + k_) * NH * 8192); __builtin_amdgcn_sched_barrier(0); }
#define SCAN_COMP(arr, c) _Pragma("unroll") for (int k_ = 0; k_ < 16; ++k_) { const int ch = 16 * (c) + k_; const float dc = dcp[(size_t)ch * NH]; \
            v4u o; o.x = pk2(st[0], st[1]); o.y = pk2(st[2], st[3]); o.z = pk2(st[4], st[5]); o.w = pk2(st[6], st[7]); *(v4u*)(Sp + (size_t)ch * NH * 8192) = o; \
            float f[8]; unpack8(arr[k_], f); \
            _Pragma("unroll") for (int j = 0; j < 8; ++j) st[j] = st[j] * dc + f[j]; }
        static_assert(NCHK == 64, "scan unrolled for 64 chunks");
        SCAN_LOAD(sa, 0) SCAN_LOAD(sb, 1)
        SCAN_COMP(sa, 0) SCAN_LOAD(sa, 2)
        SCAN_COMP(sb, 1) SCAN_LOAD(sb, 3)
        SCAN_COMP(sa, 2) SCAN_COMP(sb, 3)
#undef SCAN_LOAD
#undef SCAN_COMP
    }
}
__device__ __forceinline__ void ssd_out_phase(const Args& a, LAS unsigned char* lds, int wg, int G, int wave) {
    const bf16* H = (const bf16*)((const unsigned char*)a.out + DO_S); const bf16* Z = (const bf16*)(a.ws + WS_Z); bf16* g2 = (bf16*)(a.ws + WS_G2);
    LAS unsigned char* Cl = lds + SS_C; LAS unsigned char* CBl = lds + SS_CB; LAS unsigned char* Bl = lds + SS_X; LAS unsigned char* XT = lds + SS_X;
    for (int u = wg; u < NBATCH * NCHK * NG; u += G) {
        const int g = u & 1, c = (u >> 1) & (NCHK - 1), b = u >> 7, h = 8 * g + wave;
        const int lane = lane_id_v(); const int r = lane & 15, q = lane >> 4;
        __syncthreads();
        ssd_tables<1>(a, lds, b, c, g, wave, lane);
        bf16x8 hf[4][4];
        { const bf16* Hp = H + ((((size_t)b * NCHK + c) * NH + h) * 64) * 128 + (16 * (r >> 2) + (r & 3)) * 128 + 8 * q;
#pragma unroll
          for (int ks = 0; ks < 4; ++ks)
#pragma unroll
              for (int pt = 0; pt < 4; ++pt) hf[ks][pt] = *(const bf16x8*)(Hp + 4 * pt * 128 + 32 * ks); }
        conv_stage<false, false>(a, Cl, SS_LD, b, c, 1280 + 128 * g, 32, 0, 16, nullptr, wave);
        conv_stage<false, false>(a, Bl, SS_LD, b, c, 1024 + 128 * g, 32, 0, 16, nullptr, wave);
        __syncthreads();
        { bf16x8 cf[4];
#pragma unroll
          for (int ks = 0; ks < 4; ++ks) cf[ks] = *(const LAS bf16x8*)(Cl + (16 * wave + r) * SS_LD + (32 * ks + 8 * q) * 2);
          for (int jt = 0; jt <= wave; ++jt) { f32x4 d = (f32x4){0.f, 0.f, 0.f, 0.f};
#pragma unroll
              for (int ks = 0; ks < 4; ++ks) { const bf16x8 bf = *(const LAS bf16x8*)(Bl + (16 * jt + r) * SS_LD + (32 * ks + 8 * q) * 2); d = MFMA16(bf, cf[ks], d); }
              v2u w; w.x = pk2(d[0], d[1]); w.y = pk2(d[2], d[3]); *(LAS v2u*)(CBl + (16 * wave + r) * SS_LD + (16 * jt + 4 * q) * 2) = w; } }
        f32x4 acc[8][4];
#pragma unroll
        for (int it = 0; it < 8; ++it)
#pragma unroll
            for (int pt = 0; pt < 4; ++pt) acc[it][pt] = (f32x4){0.f, 0.f, 0.f, 0.f};
#pragma unroll
        for (int ks = 0; ks < 4; ++ks) {
#pragma unroll
            for (int it = 0; it < 8; ++it) { const bf16x8 cf = *(const LAS bf16x8*)(Cl + (16 * it + r) * SS_LD + (32 * ks + 8 * q) * 2);
#pragma unroll
                for (int pt = 0; pt < 4; ++pt) acc[it][pt] = MFMA16(hf[ks][pt], cf, acc[it][pt]); __builtin_amdgcn_sched_barrier(0); } }
        const LAS float* acw = (const LAS float*)(lds + SS_ACUM) + wave * 128; const LAS float* e2w = (const LAS float*)(lds + SS_E2) + wave * 128; const LAS float* eiw = (const LAS float*)(lds + SS_EI) + wave * 128;
#pragma unroll
        for (int it = 0; it < 8; ++it) { const float e = eiw[16 * it + r];
#pragma unroll
            for (int pt = 0; pt < 4; ++pt) acc[it][pt] = acc[it][pt] * e; }
        const float Dh = a.in[I_DSKIP][h];
        for (int jh = 0; jh < 2; ++jh) {
            __syncthreads();
            conv_stage<true, false>(a, XT, SS_XLD, b, c, 512 * g, 128, 64 * jh, 8, nullptr, wave);
            __syncthreads();
#pragma unroll
            for (int kk = 0; kk < 2; ++kk) { const int ks = 2 * jh + kk; const int jb = 32 * ks + 8 * q;
                bf16x8 xf[4];
#pragma unroll
                for (int pt = 0; pt < 4; ++pt) xf[pt] = *(const LAS bf16x8*)(XT + (64 * wave + 16 * (r >> 2) + 4 * pt + (r & 3)) * SS_XLD + (32 * kk + 8 * q) * 2);
                const f32x4 ea = *(const LAS f32x4*)(e2w + jb), eb = *(const LAS f32x4*)(e2w + jb + 4); const float Rk = ((const LAS float*)(lds + SS_R))[wave * 4 + ks];
                const float e2v[8] = {ea[0], ea[1], ea[2], ea[3], eb[0], eb[1], eb[2], eb[3]};
#pragma unroll
                for (int it = 0; it < 8; ++it) { if (16 * it + 15 < 32 * ks) continue;
                    const int i = 16 * it + r; const v4u cbv = *(const LAS v4u*)(CBl + i * SS_LD + jb * 2);
                    float cbf[8]; unpack8(cbv, cbf); const float e1 = __expf(acw[i] - Rk); float mv[8];
                    if (16 * it >= 32 * ks + 32) {
#pragma unroll
                        for (int jj = 0; jj < 8; ++jj) mv[jj] = cbf[jj] * (e1 * e2v[jj]);
                    } else {
#pragma unroll
                        for (int jj = 0; jj < 8; ++jj) { float v = cbf[jj] * (e1 * e2v[jj]); const int j = jb + jj; v = (j <= i) ? v : 0.f; v = (j == i) ? v + Dh : v; mv[jj] = v; } }
                    v4u mw; mw.x = pk2_hw(mv[0], mv[1]); mw.y = pk2_hw(mv[2], mv[3]); mw.z = pk2_hw(mv[4], mv[5]); mw.w = pk2_hw(mv[6], mv[7]);
                    const bf16x8 mf = __builtin_bit_cast(bf16x8, mw);
#pragma unroll
                    for (int pt = 0; pt < 4; ++pt) acc[it][pt] = MFMA16(xf[pt], mf, acc[it][pt]); __builtin_amdgcn_sched_barrier(0); }
            }
        }
        const size_t row0 = (size_t)b * SEQ + (size_t)c * CHK; float ss[8];
        const bf16* zp0 = Z + (row0 + r) * 1024 + 512 * g + 64 * wave + 16 * q;
        v4u zA[4][2], zB[4][2];
#pragma unroll
        for (int it = 0; it < 4; ++it) { zA[it][0] = *(const v4u*)(zp0 + (size_t)(16 * it) * 1024); zA[it][1] = *(const v4u*)(zp0 + (size_t)(16 * it) * 1024 + 8); }
#pragma unroll
        for (int it = 0; it < 4; ++it) { zB[it][0] = *(const v4u*)(zp0 + (size_t)(16 * (it + 4)) * 1024); zB[it][1] = *(const v4u*)(zp0 + (size_t)(16 * (it + 4)) * 1024 + 8); }
#pragma unroll
        for (int it = 0; it < 8; ++it) { ss[it] = 0.f; float zf[16]; unpack8(it < 4 ? zA[it & 3][0] : zB[it & 3][0], zf); unpack8(it < 4 ? zA[it & 3][1] : zB[it & 3][1], zf + 8);
#pragma unroll
            for (int pt = 0; pt < 4; ++pt) { f32x4 v = acc[it][pt];
                v[0] *= zf[4 * pt]; v[1] *= zf[4 * pt + 1]; v[2] *= zf[4 * pt + 2]; v[3] *= zf[4 * pt + 3]; acc[it][pt] = v;     ss[it] += (v[0] * v[0] + v[1] * v[1]) + (v[2] * v[2] + v[3] * v[3]); }
            ss[it] += bperm(ss[it], lane ^ 16); ss[it] += bperm(ss[it], lane ^ 32); __builtin_amdgcn_sched_barrier(0); }
        LAS float* ssum = (LAS float*)(lds + SS_SSUM);
        if (q == 0) {
#pragma unroll
            for (int it = 0; it < 8; ++it) ssum[wave * 128 + 16 * it + r] = ss[it]; }
        __syncthreads();
        const float* nw = a.in[I_SNW] + 512 * g + 64 * wave + 16 * q;
        const f32x4 w0 = *(const f32x4*)nw, w1 = *(const f32x4*)(nw + 4), w2 = *(const f32x4*)(nw + 8), w3 = *(const f32x4*)(nw + 12);
#pragma unroll
        for (int it = 0; it < 8; ++it) { float t = 0.f;
#pragma unroll
            for (int w = 0; w < 8; ++w) t += ssum[w * 128 + 16 * it + r];
            const float rinv = 1.0f / sqrtf(t * (1.f / 512.f) + EPS); bf16* op = g2 + (row0 + 16 * it + r) * G2_LD + 1024 + 512 * g + 64 * wave + 16 * q;
            const f32x4 v0 = acc[it][0] * rinv * w0, v1 = acc[it][1] * rinv * w1, v2 = acc[it][2] * rinv * w2, v3 = acc[it][3] * rinv * w3;
            v4u o0, o1; o0.x = pk2(v0[0], v0[1]); o0.y = pk2(v0[2], v0[3]); o0.z = pk2(v1[0], v1[1]); o0.w = pk2(v1[2], v1[3]);
            o1.x = pk2(v2[0], v2[1]); o1.y = pk2(v2[2], v2[3]); o1.z = pk2(v3[0], v3[1]); o1.w = pk2(v3[2], v3[3]);
            *(v4u*)op = o0; *(v4u*)(op + 8) = o1; }
    }
}
__device__ __forceinline__ void unpack8(const v4u v, float* f) { f[0] = bflo(v.x); f[1] = bfhi(v.x); f[2] = bflo(v.y); f[3] = bfhi(v.y); f[4] = bflo(v.z); f[5] = bfhi(v.z); f[6] = bflo(v.w); f[7] = bfhi(v.w); }
constexpr int SCD = 4;
__device__ __forceinline__ void sc_phase(const Args& a, int gw, int NGW) {
    const int lane = lane_id();
    bf16* g2 = (bf16*)(a.ws + WS_G2); const bf16* pr = (const bf16*)(a.ws + WS_U);
    const int c0 = 16 * lane;
    float w0[16], w1[16], w2[16], nw[16];
#pragma unroll
    for (int j = 0; j < 16; ++j) { w0[j] = a.in[I_SCCW][c0 + j]; w1[j] = a.in[I_SCCW][1024 + c0 + j]; w2[j] = a.in[I_SCCW][2048 + c0 + j]; nw[j] = a.in[I_SCNW][c0 + j]; }
    for (int blk = gw; blk < T / 32; blk += NGW) {
        const int r0 = blk * 32; float p1[16], p2[16];
#pragma unroll
        for (int j = 0; j < 16; ++j) { p1[j] = 0.f; p2[j] = 0.f; }
        if ((r0 % SEQ) != 0) {
            unpack8(*(const v4u*)(pr + (size_t)(r0 - 1) * 1024 + c0), p1); unpack8(*(const v4u*)(pr + (size_t)(r0 - 1) * 1024 + c0 + 8), p1 + 8);
            unpack8(*(const v4u*)(pr + (size_t)(r0 - 2) * 1024 + c0), p2); unpack8(*(const v4u*)(pr + (size_t)(r0 - 2) * 1024 + c0 + 8), p2 + 8);
        }
        v4u nx[SCD][4];
#define SC_LOADROW(q, rowv) { const size_t rl_ = (size_t)(rowv); nx[q][0] = *(const v4u*)(pr + rl_ * 1024 + c0); nx[q][1] = *(const v4u*)(pr + rl_ * 1024 + c0 + 8); \
            nx[q][2] = *(const v4u*)(g2 + rl_ * G2_LD + c0); nx[q][3] = *(const v4u*)(g2 + rl_ * G2_LD + c0 + 8); }
#pragma unroll
        for (int q = 0; q < SCD; ++q) SC_LOADROW(q, r0 + q)
        for (int rr = 0; rr < 32; rr += SCD) {
#pragma unroll
            for (int q = 0; q < SCD; ++q) { const size_t row = (size_t)(r0 + rr + q);
                float pp[16], gb[16], val[16];
                unpack8(nx[q][0], pp); unpack8(nx[q][1], pp + 8); unpack8(nx[q][2], gb); unpack8(nx[q][3], gb + 8);
                { const int rn = r0 + rr + q + SCD; SC_LOADROW(q, rn < r0 + 32 ? rn : r0 + 31) }
                float ss = 0.f;
#pragma unroll
                for (int j = 0; j < 16; ++j) { const float p0 = pp[j]; const float v = w2[j] * p0 + w1[j] * p1[j] + w0[j] * p2[j]; p2[j] = p1[j]; p1[j] = p0; val[j] = gb[j] * v; ss += val[j] * val[j]; }
                const float rinv = 1.0f / sqrtf(wave_sum(ss) * (1.f / 1024.f) + EPS);
                v4u o0, o1;
                o0.x = pk2_hw(val[0] * rinv * nw[0], val[1] * rinv * nw[1]); o0.y = pk2_hw(val[2] * rinv * nw[2], val[3] * rinv * nw[3]); o0.z = pk2_hw(val[4] * rinv * nw[4], val[5] * rinv * nw[5]); o0.w = pk2_hw(val[6] * rinv * nw[6], val[7] * rinv * nw[7]);
                o1.x = pk2_hw(val[8] * rinv * nw[8], val[9] * rinv * nw[9]); o1.y = pk2_hw(val[10] * rinv * nw[10], val[11] * rinv * nw[11]); o1.z = pk2_hw(val[12] * rinv * nw[12], val[13] * rinv * nw[13]); o1.w = pk2_hw(val[14] * rinv * nw[14], val[15] * rinv * nw[15]);
                *(v4u*)(g2 + row * G2_LD + c0) = o0; *(v4u*)(g2 + row * G2_LD + c0 + 8) = o1;
            }
        }
#undef SC_LOADROW
    }
}

__device__ __forceinline__ void p5_slow(const Args& a, LAS unsigned char* lds, int wg, int G) {
    LAS float* As = (LAS float*)lds; LAS float* Bs = As + 32 * SG_LD;
    const bf16* g2 = (const bf16*)(a.ws + WS_G2); const bf16* wt = (const bf16*)(a.ws + WS_WOUT);
    const int t = threadIdx.x, tm = t >> 5, tn = t & 31;
    for (int it = wg; it < (T / 128) * 8; it += G) {
        const int mt = it >> 3, nt = it & 7;
        float acc[8][4];
        auto arow = [&](int r) { return g2 + (size_t)(mt * 128 + r) * 2048; };
        sg_tile(As, Bs, arow, wt + (size_t)nt * 128 * 2048, 2048, 2048, acc);
#pragma unroll
        for (int i = 0; i < 8; ++i) { const size_t off = (size_t)(mt * 128 + 8 * tm + i) * D + nt * 128 + 4 * tn;
            const f32x4 xv = *(const f32x4*)(a.in[I_X] + off);
            *(f32x4*)(a.out + off) = (f32x4){xv.x + acc[i][0], xv.y + acc[i][1], xv.z + acc[i][2], xv.w + acc[i][3]}; }
    }
}

__device__ __forceinline__ void p6_slow(const Args& a, LAS unsigned char* lds, int wg, int G) {
    const int tid = threadIdx.x, lane = tid & 63, wave = tid >> 6;
    LAS unsigned* lcnt = (LAS unsigned*)lds; LAS unsigned* lbase = lcnt + 32; LAS u64* pend = (LAS u64*)(lds + 256);
    const float* h = a.out; const float* nw = a.in[I_N2W]; const float* wr = a.in[I_WR]; const float* br = a.in[I_BR];
    bf16* xn2 = (bf16*)(a.ws + WS_XN2); unsigned* gcount = (unsigned*)(a.ws + WS_CTL) + CW_GCOUNT; u64* ent = (u64*)(a.ws + WS_ENT);
    for (int tb = wg; tb < T / 256; tb += G) {
        __syncthreads();
        if (tid < 32) lcnt[tid] = 0u;
        __syncthreads();
        const int tok0 = tb * 256;
        for (int r = wave; r < 256; r += NWAVES) rms_row_to_bf16(h + (size_t)(tok0 + r) * D, nw, xn2 + (size_t)(tok0 + r) * D, lane);
        const int rl = tid >> 5, e = tid & 31;
        for (int pass = 0; pass < 16; ++pass) {
            const int rloc = pass * 16 + rl, tok = tok0 + rloc; const float* hr = h + (size_t)tok * D;
            float s = 0.f, d = 0.f;
            for (int k = 0; k < D; ++k) { const float hv = hr[k]; s += hv * hv; d += hv * nw[k] * wr[k * NE + e]; }
            const float rinv = 1.0f / sqrtf(s * (1.f / D) + EPS);
            const float v = d * rinv + br[e];
            LAS float* lg = (LAS float*)(lds + 16384);
            __syncthreads();
            lg[rl * 32 + e] = v;
            __syncthreads();
            int rank = 0; float mx = -INFINITY;
#pragma unroll
            for (int e2 = 0; e2 < 32; ++e2) { const float o = lg[rl * 32 + e2]; rank += (o > v || (o == v && e2 < e)) ? 1 : 0; mx = fmaxf(mx, o); }
            const bool sel = rank < 4;
            const float ex = sel ? __expf(v - mx) : 0.f; float sum = ex;
#pragma unroll
            for (int o = 1; o < 32; o <<= 1) sum += __shfl_xor(sum, o);
            if (sel) { const unsigned r = __hip_atomic_fetch_add(&lcnt[e], 1u, __ATOMIC_RELAXED, __HIP_MEMORY_SCOPE_WORKGROUP);
                pend[rloc * 4 + rank] = ((u64)__builtin_bit_cast(unsigned, ex / sum) << 32) | (((unsigned)e << 20) | r); }
        }
        __syncthreads();
        if (tid < 32) lbase[tid] = atomicAdd(&gcount[64 * tid], lcnt[tid]);
        __syncthreads();
        for (int i = tid; i < 1024; i += NTHREADS) { const u64 p = pend[i]; const unsigned px = (unsigned)p, ee = px >> 20, rank = px & 0xfffffu;
            ent[(size_t)ee * ENT_CAP + lbase[ee] + rank] = (p & 0xffffffff00000000ull) | (u64)(unsigned)((tok0 + (i >> 2)) * 4 + (i & 3)); }
    }
}


constexpr int R16_LD = 1028;
template <int NE_>
__device__ __forceinline__ void rows16_stage_w(LAS float* WT, const float* W, int ldw, const float* nw, int wave) {
    for (int i0 = wave * 64 + lane_id(); i0 < 1024 * NE_; i0 += NTHREADS * 8) {
        float v[8];
#pragma unroll
        for (int u = 0; u < 8; ++u) { const int i = i0 + u * NTHREADS, k = i / NE_, e = i % NE_; v[u] = nw[k] * W[(size_t)k * ldw + e]; }
#pragma unroll
        for (int u = 0; u < 8; ++u) { const int i = i0 + u * NTHREADS, k = i / NE_, e = i % NE_; WT[e * R16_LD + k] = v[u]; } }
}
template <int NE_>
__device__ __forceinline__ void rows16_dots(const LAS float* WT, const float* src  , int lane, f32x4 (&acc)[NE_ / 16], float& ssq) {
    const int row = lane & 15, kq = lane >> 4;
    const f32x4* ap = (const f32x4*)(src + (size_t)row * D) + kq;
    const LAS f32x4* bp = (const LAS f32x4*)(WT + row * R16_LD) + kq;
#pragma unroll
    for (int t = 0; t < NE_ / 16; ++t) acc[t] = (f32x4){0.f, 0.f, 0.f, 0.f};
    float s = 0.f;
    f32x4 ca[16], cb[16];
#define R16_LOAD(arr, c) _Pragma("unroll") for (int i_ = 0; i_ < 16; ++i_) arr[i_] = ap[4 * (16 * (c) + i_)];
#define R16_COMP(arr, c) _Pragma("unroll") for (int i_ = 0; i_ < 16; ++i_) { const f32x4 av = arr[i_]; const int sidx = 16 * (c) + i_; \
        s += (av[0] * av[0] + av[1] * av[1]) + (av[2] * av[2] + av[3] * av[3]); \
        _Pragma("unroll") for (int t = 0; t < NE_ / 16; ++t) { const f32x4 bv = bp[(16 * t * R16_LD) / 4 + 4 * sidx]; \
            _Pragma("unroll") for (int j = 0; j < 4; ++j) acc[t] = __builtin_amdgcn_mfma_f32_16x16x4f32(av[j], bv[j], acc[t], 0, 0, 0); } }
    R16_LOAD(ca, 0) R16_LOAD(cb, 1)
    R16_COMP(ca, 0) R16_LOAD(ca, 2)
    R16_COMP(cb, 1) R16_LOAD(cb, 3)
    R16_COMP(ca, 2) R16_COMP(cb, 3)
#undef R16_LOAD
#undef R16_COMP
    s += bperm(s, lane ^ 16); s += bperm(s, lane ^ 32); ssq = s;
}
__device__ __forceinline__ void rows16_norm_store(const float* src, const float* w, bf16* dst, int dst_ld, float rinv_lane, int lane) {
    const f32x4* wr = (const f32x4*)w + lane;
#pragma unroll 4
    for (int i = 0; i < 16; ++i) { const float rinv = bperm(rinv_lane, (lane & 48) | i); const f32x4* xr = (const f32x4*)(src + (size_t)i * D) + lane; v2u* o8 = (v2u*)(dst + (size_t)i * dst_ld) + lane;
#pragma unroll
        for (int j = 0; j < 4; ++j) { const f32x4 v = xr[64 * j], ww = wr[64 * j]; v2u o; o.x = pk2_hw(v[0] * rinv * ww[0], v[1] * rinv * ww[1]); o.y = pk2_hw(v[2] * rinv * ww[2], v[3] * rinv * ww[3]); o8[64 * j] = o; } }
}

__device__ __forceinline__ void rows16_pass_router(const LAS float* WT, const LAS float* wl, const float* src, unsigned char* dst8, int lane, f32x4 (&acc)[2], float& ssq) {
    const int row = lane & 15, kq = lane >> 4;
    const f32x4* ap = (const f32x4*)(src + (size_t)row * D + 16 * kq);
    const LAS f32x4* bp = (const LAS f32x4*)(WT + row * R16_LD + 16 * kq); const LAS f32x4* wp = (const LAS f32x4*)(wl + 16 * kq);
    v4u* op = (v4u*)(dst8 + (size_t)row * D + 16 * kq);
    acc[0] = (f32x4){0.f, 0.f, 0.f, 0.f}; acc[1] = (f32x4){0.f, 0.f, 0.f, 0.f}; float s = 0.f;
    f32x4 ca[8], cb[8], cc[8];
#define RR_LOAD(arr, c) { _Pragma("unroll") for (int i_ = 0; i_ < 8; ++i_) arr[i_] = ap[16 * (2 * (c) + (i_ >> 2)) + (i_ & 3)]; __builtin_amdgcn_sched_barrier(0); }
#define RR_COMP(arr, c) _Pragma("unroll") for (int ss_ = 0; ss_ < 2; ++ss_) { const int S = 2 * (c) + ss_; v4u o_; \
        _Pragma("unroll") for (int jp = 0; jp < 4; ++jp) { const f32x4 x = arr[4 * ss_ + jp]; s += (x[0] * x[0] + x[1] * x[1]) + (x[2] * x[2] + x[3] * x[3]); \
            { const f32x4 bv0 = bp[16 * S + jp], bv1 = bp[(16 * R16_LD) / 4 + 16 * S + jp];     \
                _Pragma("unroll") for (int j = 0; j < 4; ++j) { acc[0] = __builtin_amdgcn_mfma_f32_16x16x4f32(x[j], bv0[j], acc[0], 0, 0, 0); acc[1] = __builtin_amdgcn_mfma_f32_16x16x4f32(x[j], bv1[j], acc[1], 0, 0, 0); } } \
            const f32x4 p = x * wp[16 * S + jp]; o_[jp] = pk4_fp8(p[0], p[1], p[2], p[3]); } \
        op[4 * S] = o_; }
    RR_LOAD(ca, 0) RR_LOAD(cb, 1) RR_LOAD(cc, 2)
    RR_COMP(ca, 0) RR_LOAD(ca, 3)
    RR_COMP(cb, 1) RR_LOAD(cb, 4)
    RR_COMP(cc, 2) RR_LOAD(cc, 5)
    RR_COMP(ca, 3) RR_LOAD(ca, 6)
    RR_COMP(cb, 4) RR_LOAD(cb, 7)
    RR_COMP(cc, 5) RR_COMP(ca, 6) RR_COMP(cb, 7)
#undef RR_LOAD
#undef RR_COMP
    s += bperm(s, lane ^ 16); s += bperm(s, lane ^ 32); ssq = s;
}
__device__ __forceinline__ void rows16_norm_store8(const float* src, const float* w, unsigned char* dst, float rinv_lane, int lane) {
    const f32x4* wr = (const f32x4*)w + lane;
#pragma unroll 4
    for (int i = 0; i < 16; ++i) { const float rinv = bperm(rinv_lane, (lane & 48) | i); const f32x4* xr = (const f32x4*)(src + (size_t)i * D) + lane; unsigned* o4 = (unsigned*)(dst + (size_t)i * D) + lane;
#pragma unroll
        for (int j = 0; j < 4; ++j) { const f32x4 v = xr[64 * j], ww = wr[64 * j]; o4[64 * j] = pk4_fp8(v[0] * rinv * ww[0], v[1] * rinv * ww[1], v[2] * rinv * ww[2], v[3] * rinv * ww[3]); } }
}
__device__ __forceinline__ void rows16_pass1(const LAS float* WT, const float* src, const LAS float* w, bf16* dst, int dst_ld, int lane, f32x4& acc, float& ssq) {
    const int row = lane & 15, kq = lane >> 4;
    const f32x4* ap = (const f32x4*)(src + (size_t)row * D + 16 * kq); const LAS f32x4* wp = (const LAS f32x4*)(w + 16 * kq);
    const LAS f32x4* bp = (const LAS f32x4*)(WT + row * R16_LD + 16 * kq);
    v4u* op = (v4u*)(dst + (size_t)row * dst_ld + 16 * kq);
    acc = (f32x4){0.f, 0.f, 0.f, 0.f}; float s = 0.f;
#pragma unroll 2
    for (int S = 0; S < 16; ++S) {
        f32x4 av[4], wv[4];
#pragma unroll
        for (int jp = 0; jp < 4; ++jp) { av[jp] = ap[16 * S + jp]; wv[jp] = wp[16 * S + jp]; }
#pragma unroll
        for (int jp = 0; jp < 4; ++jp) { const f32x4 x = av[jp]; const f32x4 bv = bp[16 * S + jp]; s += (x[0] * x[0] + x[1] * x[1]) + (x[2] * x[2] + x[3] * x[3]);
#pragma unroll
            for (int j = 0; j < 4; ++j) acc = __builtin_amdgcn_mfma_f32_16x16x4f32(x[j], bv[j], acc, 0, 0, 0); }
        v4u o0, o1; const f32x4 p0 = av[0] * wv[0], p1 = av[1] * wv[1], p2 = av[2] * wv[2], p3 = av[3] * wv[3];
        o0.x = pk2_hw(p0[0], p0[1]); o0.y = pk2_hw(p0[2], p0[3]); o0.z = pk2_hw(p1[0], p1[1]); o0.w = pk2_hw(p1[2], p1[3]);
        o1.x = pk2_hw(p2[0], p2[1]); o1.y = pk2_hw(p2[2], p2[3]); o1.z = pk2_hw(p3[0], p3[1]); o1.w = pk2_hw(p3[2], p3[3]);
        op[8 * S] = o0; op[8 * S + 1] = o1;
    }
    s += bperm(s, lane ^ 16); s += bperm(s, lane ^ 32); ssq = s;
}
__device__ __forceinline__ void p0_rows_fast(const Args& a, LAS unsigned char* lds, int gw, int NGW, int wave) {
    LAS float* WT = (LAS float*)lds;
    __syncthreads();
    rows16_stage_w<16>(WT, a.in[I_WIN] + DT_COL0, PROJ_DIM, a.in[I_N1W], wave);
    LAS float* wl = (LAS float*)(lds + 66048);
    { const int tid = wave * 64 + lane_id(); wl[tid] = a.in[I_N1W][tid]; wl[tid + 512] = a.in[I_N1W][tid + 512]; }
    __syncthreads();
    float* dt = (float*)(a.ws + WS_DT); bf16* xn = (bf16*)((unsigned char*)a.out + DO_XN); float* rinvt = (float*)(a.ws + WS_RINV);
    for (int grp = gw; grp < T / 16; grp += NGW) {
        const int lane = lane_id_v();
        const float* src = a.in[I_X] + (size_t)grp * 16 * D;
        f32x4 acc; float ssq; rows16_pass1(WT, src, wl, xn + (size_t)grp * 16 * XN_LD, XN_LD, lane, acc, ssq);
        const float rinv = 1.0f / sqrtf(ssq * (1.f / D) + EPS);
        if (lane < 16) rinvt[(size_t)grp * 16 + lane] = rinv;
#pragma unroll
        for (int reg = 0; reg < 4; ++reg) { const int rr = 4 * (lane >> 4) + reg; const float ri = bperm(rinv, (lane & 48) | rr); dt[((size_t)grp * 16 + rr) * 16 + (lane & 15)] = softplus_f(acc[reg] * ri + a.in[I_DTB][lane & 15]); }
    }
}
__device__ __forceinline__ void p6_fast(const Args& a, LAS unsigned char* lds, int wg, int G, int wave) {
    LAS float* WT = (LAS float*)lds; LAS float* lg = (LAS float*)(lds + 131584) + wave * 512;
    LAS unsigned* lcnt = (LAS unsigned*)(lds + 147968); LAS unsigned* lbase = lcnt + 32; LAS u64* pend = (LAS u64*)(lds + 148224);
    LAS float* rinv_l = (LAS float*)(lds + 156416); LAS float* wl = (LAS float*)(lds + 157440);
    float* erinv = (float*)(a.ws + WS_ERINV);
    const float* h = a.out; bf16* xn2 = (bf16*)(a.ws + WS_XN2); unsigned* gcount = (unsigned*)(a.ws + WS_CTL) + CW_GCOUNT; u64* ent = (u64*)(a.ws + WS_ENT);
    __syncthreads();
    rows16_stage_w<32>(WT, a.in[I_WR], NE, a.in[I_N2W], wave);
    { const int tid = wave * 64 + lane_id(); wl[tid] = a.in[I_N2W][tid]; wl[tid + 512] = a.in[I_N2W][tid + 512]; }
    for (int tb = wg; tb < T / 256; tb += G) {
        __syncthreads();
        { const int tid = wave * 64 + lane_id(); if (tid < 32) lcnt[tid] = 0u; }
        __syncthreads();
        const int tok0 = tb * 256;
        for (int gi = 0; gi < 2; ++gi) {
            const int lane = lane_id_v();
            const int rbase = (wave * 2 + gi) * 16; const float* src = h + (size_t)(tok0 + rbase) * D;
            f32x4 acc[2]; float ssq; rows16_pass_router(WT, wl, src, (unsigned char*)xn2 + (size_t)(tok0 + rbase) * D, lane, acc, ssq);
            const float rinv = 1.0f / sqrtf(ssq * (1.f / D) + EPS);
            if (lane < 16) rinv_l[rbase + lane] = rinv;
            const int c = lane & 15, q = lane >> 4; const float b0 = a.in[I_BR][c], b1 = a.in[I_BR][16 + c];
#pragma unroll
            for (int reg = 0; reg < 4; ++reg) { const int rr = 4 * q + reg; const float ri = bperm(rinv, (lane & 48) | rr); lg[rr * 32 + c] = acc[0][reg] * ri + b0; lg[rr * 32 + 16 + c] = acc[1][reg] * ri + b1; }
            LDS_WAIT(); asm volatile("" ::: "memory");
            { const int tl = lane >> 2, part = lane & 3; float mine[8]; int rk[8];
              { const f32x4 m0 = *(const LAS f32x4*)(lg + tl * 32 + 8 * part), m1 = *(const LAS f32x4*)(lg + tl * 32 + 8 * part + 4);
                mine[0] = m0[0]; mine[1] = m0[1]; mine[2] = m0[2]; mine[3] = m0[3]; mine[4] = m1[0]; mine[5] = m1[1]; mine[6] = m1[2]; mine[7] = m1[3]; }
              unsigned km[8];
#pragma unroll
              for (int m = 0; m < 8; ++m) { rk[m] = 0; unsigned bb = __builtin_bit_cast(unsigned, mine[m]); bb ^= ((unsigned)((int)bb >> 31) | 0x80000000u); km[m] = (bb & ~31u) | (unsigned)(31 - (8 * part + m)); }
              float mx = -INFINITY;
#pragma unroll
              for (int j4 = 0; j4 < 8; ++j4) { const f32x4 v = *(const LAS f32x4*)(lg + tl * 32 + 4 * j4);
#pragma unroll
                  for (int jj = 0; jj < 4; ++jj) { const float o = v[jj]; mx = fmaxf(mx, o); unsigned bb = __builtin_bit_cast(unsigned, o); bb ^= ((unsigned)((int)bb >> 31) | 0x80000000u); const unsigned ko = (bb & ~31u) | (unsigned)(31 - (4 * j4 + jj));
#pragma unroll
                      for (int m = 0; m < 8; ++m) rk[m] += (ko > km[m]) ? 1 : 0; } }
              float exs = 0.f;
#pragma unroll
              for (int m = 0; m < 8; ++m) if (rk[m] < 4) exs += __expf(mine[m] - mx);
              exs += bperm(exs, lane ^ 1); exs += bperm(exs, lane ^ 2);
              const float inv = 1.0f / exs;
#pragma unroll
              for (int m = 0; m < 8; ++m) if (rk[m] < 4) { const int e = 8 * part + m; const unsigned rnk = __hip_atomic_fetch_add(&lcnt[e], 1u, __ATOMIC_RELAXED, __HIP_MEMORY_SCOPE_WORKGROUP);
                  pend[(rbase + tl) * 4 + rk[m]] = ((u64)__builtin_bit_cast(unsigned, __expf(mine[m] - mx) * inv) << 32) | (((unsigned)e << 20) | rnk); }
            }
            LDS_WAIT(); asm volatile("" ::: "memory");
        }
        __syncthreads();
        const int tid = wave * 64 + lane_id();
        if (tid < 32) lbase[tid] = atomicAdd(&gcount[64 * tid], lcnt[tid]);
        __syncthreads();
        for (int i = tid; i < 1024; i += NTHREADS) { const u64 p = pend[i]; const unsigned px = (unsigned)p, ee = px >> 20, rank = px & 0xfffffu;
            const size_t ei = (size_t)ee * ENT_CAP + lbase[ee] + rank;
            ent[ei] = (p & 0xffffffff00000000ull) | (u64)(unsigned)((tok0 + (i >> 2)) * 4 + (i & 3)); erinv[ei] = rinv_l[i >> 2]; }
    }
}
__device__ __forceinline__ void moe_tables(const Args& a, LAS unsigned* tab, int wave = -1) {
    const unsigned* gcount = (const unsigned*)(a.ws + WS_CTL) + CW_GCOUNT; const int tidx = wave < 0 ? (int)threadIdx.x : wave * 64 + lane_id();
    __syncthreads();
    if (tidx < 32) tab[tidx] = __hip_atomic_load(gcount + 64 * tidx, __ATOMIC_RELAXED, __HIP_MEMORY_SCOPE_AGENT);
    __syncthreads();
    if (tidx == 0) { unsigned p = 0; for (int e = 0; e < 32; ++e) { tab[32 + e] = p; p += (tab[e] + 255u) >> 8; } tab[64] = p; }
    __syncthreads();
}
__device__ __forceinline__ int moe_find_e(const LAS unsigned* tab, int gp) { int e = 0;
#pragma unroll
    for (int s = 16; s >= 1; s >>= 1) if (tab[32 + e + s] <= (unsigned)gp) e += s;
    return e; }
__device__ __forceinline__ float swiglu_f(float g, float u) { g = fminf(g, SWI_LIMIT); u = fminf(fmaxf(u, -SWI_LIMIT), SWI_LIMIT); return (u + 1.0f) * (g / (1.0f + __expf(-SWI_ALPHA * g))); }

__device__ __forceinline__ void p7_slow(const Args& a, LAS unsigned char* lds, int wg, int G) {
    LAS unsigned* tab = (LAS unsigned*)(lds + 40960); moe_tables(a, tab);
    LAS float* As = (LAS float*)lds; LAS float* Bs = As + 32 * SG_LD;
    const bf16* xn2 = (const bf16*)(a.ws + WS_XN2); const bf16* wgu = (const bf16*)(a.ws + WS_WGU); const u64* ent = (const u64*)(a.ws + WS_ENT);
    bf16* hid = (bf16*)(a.ws + WS_HID);
    const int t = threadIdx.x, tm = t >> 5, tn = t & 31, NP = (int)tab[64];
    for (int it = wg; it < NP * 16; it += G) {
        const int gp = it >> 4, half = (it >> 3) & 1, jt = it & 7, e = moe_find_e(tab, gp), pl = gp - (int)tab[32 + e], cnt = (int)tab[e];
        auto arow = [&](int r) { int pos = pl * 256 + half * 128 + r; pos = pos < cnt ? pos : cnt - 1; const unsigned tok = (unsigned)ent[(size_t)e * ENT_CAP + pos] >> 2; return xn2 + (size_t)tok * D; };
        float ag[8][4], au[8][4];
        const bf16* wb = wgu + (size_t)e * 2048 * D + (size_t)(256 * jt) * D;
        sg_tile(As, Bs, arow, wb, D, D, ag);
        sg_tile(As, Bs, arow, wb + (size_t)128 * D, D, D, au);
        const int j0 = 128 * jt + 4 * tn; const float* bg = a.in[I_BGU] + (size_t)e * 2048 + j0; const float* bu = bg + 1024;
#pragma unroll
        for (int i = 0; i < 8; ++i) { const size_t row = (size_t)gp * 256 + half * 128 + 8 * tm + i;
            v2u o; o.x = pk2(swiglu_f(ag[i][0] + bg[0], au[i][0] + bu[0]), swiglu_f(ag[i][1] + bg[1], au[i][1] + bu[1]));
            o.y = pk2(swiglu_f(ag[i][2] + bg[2], au[i][2] + bu[2]), swiglu_f(ag[i][3] + bg[3], au[i][3] + bu[3]));
            *(v2u*)(hid + row * FF + j0) = o; }
    }
}
__device__ __forceinline__ bf16* slot_ptr(unsigned char* ws, int k) { return (bf16*)(ws + (k == 0 ? WS_SLOT0 : (k == 1 ? WS_SLOT1 : (k == 2 ? WS_SLOT2 : WS_SLOT3)))); }
__device__ __forceinline__ void p8_slow(const Args& a, LAS unsigned char* lds, int wg, int G) {
    LAS unsigned* tab = (LAS unsigned*)(lds + 40960); moe_tables(a, tab);
    LAS float* As = (LAS float*)lds; LAS float* Bs = As + 32 * SG_LD;
    const bf16* hid = (const bf16*)(a.ws + WS_HID); const bf16* wd = (const bf16*)(a.ws + WS_WD); const u64* ent = (const u64*)(a.ws + WS_ENT);
    const int t = threadIdx.x, tm = t >> 5, tn = t & 31, NP = (int)tab[64];
    for (int it = wg; it < NP * 16; it += G) {
        const int gp = it >> 4, half = (it >> 3) & 1, nt = it & 7, e = moe_find_e(tab, gp), pl = gp - (int)tab[32 + e], cnt = (int)tab[e];
        auto arow = [&](int r) { return hid + ((size_t)gp * 256 + half * 128 + r) * FF; };
        float acc[8][4];
        sg_tile(As, Bs, arow, wd + (size_t)e * D * FF + (size_t)(128 * nt) * FF, FF, FF, acc);
        const int c0 = 128 * nt + 4 * tn; const float* bd = a.in[I_BD] + (size_t)e * D + c0;
#pragma unroll
        for (int i = 0; i < 8; ++i) { const int pos = pl * 256 + half * 128 + 8 * tm + i; if (pos >= cnt) continue;
            const u64 en = ent[(size_t)e * ENT_CAP + pos]; const unsigned enx = (unsigned)en; const float gt = __builtin_bit_cast(float, (unsigned)(en >> 32)); const int k = enx & 3; const size_t tok = enx >> 2;
            const float v0 = (acc[i][0] + bd[0]) * gt, v1 = (acc[i][1] + bd[1]) * gt, v2 = (acc[i][2] + bd[2]) * gt, v3 = (acc[i][3] + bd[3]) * gt;
            if (k == 0) { f32x4* p = (f32x4*)(a.out + tok * D + c0); const f32x4 o = *p; *p = (f32x4){o.x + v0, o.y + v1, o.z + v2, o.w + v3}; }
            else { v2u o; o.x = pk2(v0, v1); o.y = pk2(v2, v3); *(v2u*)(slot_ptr(a.ws, k) + tok * D + c0) = o; } }
    }
}

constexpr int EBUF_OFF = 131072 + 4096;
constexpr int TAB_OFF = 131072;
struct EpiProj {
    static constexpr bool PERM = true; static constexpr int NST = 8; unsigned char* ws;
    __device__ __forceinline__ void dma(const pg8::Unit& u, LAS unsigned char* eb, int wid, int lane) const {
        if (wid == 0) __builtin_amdgcn_global_load_lds((const unsigned*)((const float*)(ws + WS_RINV) + u.pm * 256 + 4 * lane), (LAS unsigned*)eb, 16, 0, 0);
    }
    __device__ __forceinline__ void operator()(const f32x4 (&acc)[2][2][4][2], const pg8::Unit& u, int wr, int wc, int fr, int fq, const LAS unsigned char* eb) const {
        const LAS float* rinvt = (const LAS float*)eb + wr * 64 + fr; float ri[2][4];
#pragma unroll
        for (int ai = 0; ai < 2; ++ai)
#pragma unroll
            for (int m = 0; m < 4; ++m) ri[ai][m] = rinvt[ai * 128 + m * 16];
        const int pn = u.pn; bf16* base; int ldc, colt;
        if (pn < 4) { base = (bf16*)(ws + WS_Z); ldc = 1024; colt = 256 * pn; } else if (pn < 10) { base = (bf16*)(ws + WS_XBC); ldc = DXBC; colt = 256 * (pn - 4); }
        else { base = (bf16*)(ws + WS_G2); ldc = G2_LD; colt = 256 * (pn - 10); }
        const int row0 = u.pm * 256 + wr * 64 + fr, col0 = colt + wc * 32 + 8 * fq;
        if (pn >= 14) {
            bf16* pb = (bf16*)(ws + WS_U) + (size_t)row0 * 1024 + 128 * (pn - 14) + wc * 32 + 8 * fq;
#pragma unroll
            for (int ai = 0; ai < 2; ++ai)
#pragma unroll
                for (int m = 0; m < 4; ++m) { const float r2 = ri[ai][m] * ri[ai][m];
                    const f32x4 v0 = acc[ai][0][m][0] * acc[ai][1][m][0] * r2, v1 = acc[ai][0][m][1] * acc[ai][1][m][1] * r2;
                    v4u w; w.x = pg8::cvt_pk_bf16(v0[0], v0[1]); w.y = pg8::cvt_pk_bf16(v0[2], v0[3]); w.z = pg8::cvt_pk_bf16(v1[0], v1[1]); w.w = pg8::cvt_pk_bf16(v1[2], v1[3]);
                    *(v4u*)(pb + (size_t)(ai * 128 + m * 16) * 1024) = w; }
            return; }
#pragma unroll
        for (int ai = 0; ai < 2; ++ai)
#pragma unroll
            for (int m = 0; m < 4; ++m) { bf16* rowp = base + (size_t)(row0 + ai * 128 + m * 16) * ldc + col0;
#pragma unroll
                for (int bj = 0; bj < 2; ++bj) { f32x4 v0 = acc[ai][bj][m][0] * ri[ai][m], v1 = acc[ai][bj][m][1] * ri[ai][m];
                    if (pn < 4) {
#pragma unroll
                        for (int j = 0; j < 4; ++j) { v0[j] = silu_fast(v0[j]); v1[j] = silu_fast(v1[j]); } }
                    v4u w; w.x = pg8::cvt_pk_bf16(v0[0], v0[1]); w.y = pg8::cvt_pk_bf16(v0[2], v0[3]); w.z = pg8::cvt_pk_bf16(v1[0], v1[1]); w.w = pg8::cvt_pk_bf16(v1[2], v1[3]);
                    *(v4u*)(rowp + bj * 128) = w; } }
    }
};
struct EpiResid {
    static constexpr bool PERM = false; static constexpr int NST = 32; const float* x; float* out;
    __device__ __forceinline__ void dma(const pg8::Unit&, LAS unsigned char*, int, int) const {}
    __device__ __forceinline__ void operator()(const f32x4 (&acc)[2][2][4][2], const pg8::Unit& u, int wr, int wc, int fr, int fq, const LAS unsigned char*) const {
        const int row0 = u.pm * 256 + wr * 64 + fr, col0 = u.pn * 256 + wc * 32 + 4 * fq;
#pragma unroll
        for (int ai = 0; ai < 2; ++ai)
#pragma unroll
            for (int m = 0; m < 4; ++m) { const size_t off = (size_t)(row0 + ai * 128 + m * 16) * D + col0;
#pragma unroll
                for (int bj = 0; bj < 2; ++bj)
#pragma unroll
                    for (int n = 0; n < 2; ++n) { const f32x4 xv = *(const f32x4*)(x + off + bj * 128 + n * 16); *(f32x4*)(out + off + bj * 128 + n * 16) = xv + acc[ai][bj][m][n]; } }
    }
};

constexpr float W8_SCALE = 32.0f, W8_INV = 1.0f / 32.0f;
__device__ __forceinline__ float clamp448(float v) { return __builtin_amdgcn_fmed3f(v, -448.f, 448.f); }
__device__ __forceinline__ unsigned pk4_fp8(float a, float b, float c, float d) { unsigned w = 0; w = __builtin_amdgcn_cvt_pk_fp8_f32(clamp448(a), clamp448(b), w, false); w = __builtin_amdgcn_cvt_pk_fp8_f32(clamp448(c), clamp448(d), w, true); return w; }
__device__ __forceinline__ unsigned pk4_fp8_nc(float a, float b, float c, float d) { unsigned w = 0; w = __builtin_amdgcn_cvt_pk_fp8_f32(a, b, w, false); w = __builtin_amdgcn_cvt_pk_fp8_f32(c, d, w, true); return w; }
__device__ __forceinline__ float swiglu_fast(float g, float u1) { g = fminf(g, SWI_LIMIT); u1 = __builtin_amdgcn_fmed3f(u1, 1.0f - SWI_LIMIT, 1.0f + SWI_LIMIT);
    return u1 * g * __builtin_amdgcn_rcpf(1.0f + __builtin_amdgcn_exp2f(g * (-SWI_ALPHA * 1.44269504f))); }
struct EpiSwiglu {
    static constexpr bool PERM = true; static constexpr int NST = 8; const float* bgu; unsigned char* hid; const float* erinv; const LAS unsigned* tab;
    __device__ __forceinline__ void dma(const pg8::Unit& u, LAS unsigned char* eb, int wid, int lane) const {
        const int e = u.aux;
        if (wid == 0) __builtin_amdgcn_global_load_lds((const unsigned*)(bgu + (size_t)e * 2048 + (lane >> 5) * 1024 + 128 * u.pn + 4 * (lane & 31)), (LAS unsigned*)eb, 16, 0, 0);
        if (wid == 1) { const int pl = u.pm - (int)tab[32 + e]; __builtin_amdgcn_global_load_lds((const unsigned*)(erinv + (size_t)e * ENT_CAP + pl * 256 + 4 * lane), (LAS unsigned*)(eb + 1024), 16, 0, 0); }
    }
    __device__ __forceinline__ void operator()(const f32x4 (&acc)[2][2][4][2], const pg8::Unit& u, int wr, int wc, int fr, int fq, const LAS unsigned char* eb) const {
        const int j0 = 128 * u.pn + wc * 32 + 8 * fq; const LAS float* bg = (const LAS float*)eb + wc * 32 + 8 * fq;
        const f32x4 g0 = *(const LAS f32x4*)bg, g1 = *(const LAS f32x4*)(bg + 4), u0 = *(const LAS f32x4*)(bg + 128) + 1.0f, u1 = *(const LAS f32x4*)(bg + 132) + 1.0f;
        const LAS float* erp = (const LAS float*)(eb + 1024) + wr * 64 + fr; float rs[2][4];
#pragma unroll
        for (int ai = 0; ai < 2; ++ai)
#pragma unroll
            for (int m = 0; m < 4; ++m) rs[ai][m] = erp[ai * 128 + m * 16];
#pragma unroll
        for (int ai = 0; ai < 2; ++ai) {
#pragma unroll
            for (int m = 0; m < 4; ++m) { const size_t row = (size_t)u.pm * 256 + ai * 128 + wr * 64 + m * 16 + fr;
                const float rsc = rs[ai][m] * W8_INV; const f32x4 a0 = acc[ai][0][m][0] * rsc + g0, a1 = acc[ai][0][m][1] * rsc + g1, b0 = acc[ai][1][m][0] * rsc + u0, b1 = acc[ai][1][m][1] * rsc + u1;
                v2u w; w.x = pk4_fp8_nc(swiglu_fast(a0[0], b0[0]), swiglu_fast(a0[1], b0[1]), swiglu_fast(a0[2], b0[2]), swiglu_fast(a0[3], b0[3]));
                w.y = pk4_fp8_nc(swiglu_fast(a1[0], b1[0]), swiglu_fast(a1[1], b1[1]), swiglu_fast(a1[2], b1[2]), swiglu_fast(a1[3], b1[3]));
                *(v2u*)(hid + row * FF + j0) = w; } }
    }
};
struct EpiDown {
    static constexpr bool PERM = true; static constexpr int NST = 0; const float* bd; const u64* ent; const LAS unsigned* tab; float* out; unsigned char* ws;
    __device__ __forceinline__ void dma(const pg8::Unit& u, LAS unsigned char* eb, int wid, int lane) const {
        const int e = u.aux;
        if (wid == 0) __builtin_amdgcn_global_load_lds((const unsigned*)(bd + (size_t)e * D + 256 * u.pn + 4 * lane), (LAS unsigned*)eb, 16, 0, 0);
        if (wid == 1 || wid == 2) { const int pl = u.pm - (int)tab[32 + e];
            __builtin_amdgcn_global_load_lds((const unsigned*)(ent + (size_t)e * ENT_CAP + pl * 256 + 128 * (wid - 1) + 2 * lane), (LAS unsigned*)(eb + 1024 + 1024 * (wid - 1)), 16, 0, 0); }
    }
    __device__ __forceinline__ void operator()(const f32x4 (&acc)[2][2][4][2], const pg8::Unit& u, int wr, int wc, int fr, int fq, const LAS unsigned char* eb) const {
        const int e = u.aux, pl = u.pm - (int)tab[32 + e], cnt = (int)tab[e], c0 = 256 * u.pn + wc * 32 + 8 * fq; const LAS float* bp = (const LAS float*)eb + wc * 32 + 8 * fq;
        f32x4 bv[2][2];
#pragma unroll
        for (int bj = 0; bj < 2; ++bj) { bv[bj][0] = *(const LAS f32x4*)(bp + bj * 128); bv[bj][1] = *(const LAS f32x4*)(bp + bj * 128 + 4); }
        const LAS u64* enp = (const LAS u64*)(eb + 1024) + wr * 64 + fr; u64 en8[2][4];
#pragma unroll
        for (int ai = 0; ai < 2; ++ai)
#pragma unroll
            for (int m = 0; m < 4; ++m) en8[ai][m] = enp[ai * 128 + m * 16];
#pragma unroll
        for (int ai = 0; ai < 2; ++ai)
#pragma unroll
            for (int m = 0; m < 4; ++m) { const int pos = pl * 256 + ai * 128 + wr * 64 + m * 16 + fr; if (pos >= cnt) continue;
                const u64 en = en8[ai][m]; const unsigned enx = (unsigned)en; const float gt = __builtin_bit_cast(float, (unsigned)(en >> 32)); const int k = enx & 3; const size_t tok = enx >> 2;
                bf16* dst = slot_ptr(ws, k) + tok * D + c0;
#pragma unroll
                for (int bj = 0; bj < 2; ++bj) { const f32x4 v0 = (acc[ai][bj][m][0] * W8_INV + bv[bj][0]) * gt, v1 = (acc[ai][bj][m][1] * W8_INV + bv[bj][1]) * gt;
                    v4u w; w.x = pg8::cvt_pk_bf16(v0[0], v0[1]); w.y = pg8::cvt_pk_bf16(v0[2], v0[3]); w.z = pg8::cvt_pk_bf16(v1[0], v1[1]); w.w = pg8::cvt_pk_bf16(v1[2], v1[3]);
                    *(v4u*)(dst + bj * 128) = w; } }
    }
};
struct MoeSched {
    const LAS unsigned* tab; int NP, npn, G, vc; const u64* ent; const char* Bt; size_t estepB, tstepB; bool gather; unsigned rowB, ldbB;
    __device__ __forceinline__ void init(const LAS unsigned* tab_, int npn_, int G_, int c, const u64* ent_, const void* Bt_, size_t estepB_, size_t tstepB_, bool gather_, unsigned rowB_) { rowB = rowB_; ldbB = rowB_;
        tab = tab_; NP = (int)tab_[64]; npn = npn_; G = G_; vc = (G_ % 8 == 0) ? (c & 7) * (G_ / 8) + (c >> 3) : c; ent = ent_; Bt = (const char*)Bt_; estepB = estepB_; tstepB = tstepB_; gather = gather_; }
    bool rev = false;
    __device__ __forceinline__ bool next(int i, pg8::Unit& u) const { int ug = i * G + vc; if (ug >= NP * npn) return false; if (rev) ug = NP * npn - 1 - ug; u.pm = ug / npn; u.pn = ug % npn; u.aux = moe_find_e(tab, u.pm); return true; }
    __device__ __forceinline__ void a_offs(const pg8::Unit& u, int tid, unsigned (&o0)[2], unsigned (&o1)[2]) const {
        int R[2], C[2]; pg8::stage_rc(tid * 16, R[0], C[0]); pg8::stage_rc(tid * 16 + 8192, R[1], C[1]);
        if (gather) { const int e = u.aux, pl = u.pm - (int)tab[32 + e], cnt = (int)tab[e];
#pragma unroll
            for (int i = 0; i < 2; ++i) { int p0 = pl * 256 + R[i], p1 = p0 + 128; p0 = p0 < cnt ? p0 : cnt - 1; p1 = p1 < cnt ? p1 : cnt - 1;
                const unsigned t0 = (unsigned)ent[(size_t)e * ENT_CAP + p0] >> 2, t1 = (unsigned)ent[(size_t)e * ENT_CAP + p1] >> 2;
                o0[i] = t0 * rowB + (unsigned)C[i] * 2u; o1[i] = t1 * rowB + (unsigned)C[i] * 2u; } }
        else {
#pragma unroll
            for (int i = 0; i < 2; ++i) { o0[i] = (unsigned)(u.pm * 256 + R[i]) * rowB + (unsigned)C[i] * 2u; o1[i] = o0[i] + 128u * rowB; } }
    }
    __device__ __forceinline__ const char* b_base(const pg8::Unit& u) const { return Bt + (size_t)u.aux * estepB + (size_t)u.pn * tstepB; }
};
__device__ __forceinline__ void p1_fast(const Args& a, LAS unsigned char* lds, int wg, int G, int wave) {
    pg8::DenseSched S; S.init(T, NPROJ, G, wg, XN_LD); S.GS = 4; S.Bt = (const char*)(a.ws + WS_WIN); S.tstepB = (size_t)256 * WIN_LD * 2; S.ldbB = WIN_LD * 2;
    EpiProj E{a.ws};
    pg8::gemm_phase<EpiProj, pg8::DenseSched, true>(lds, (const char*)a.out + DO_XN, D, S, E, wave);
}
__device__ __forceinline__ void p5_fast(const Args& a, LAS unsigned char* lds, int wg, int G, int wave) {
    pg8::DenseSched S; S.init(T, D, G, wg, G2_LD); S.rev = true; S.Bt = (const char*)(a.ws + WS_WOUT); S.tstepB = (size_t)256 * WOUT_LD * 2; S.ldbB = WOUT_LD * 2;
    EpiResid E{a.in[I_X], a.out};
    pg8::gemm_phase<EpiResid, pg8::DenseSched, true>(lds, (const char*)(a.ws + WS_G2), 2048, S, E, wave);
}
__device__ __forceinline__ void p7_fast(const Args& a, LAS unsigned char* lds, int wg, int G, int wave) {
    LAS unsigned* tab = (LAS unsigned*)(lds + TAB_OFF); moe_tables(a, tab, wave);
    MoeSched S; S.init(tab, 8, G, wg, (const u64*)(a.ws + WS_ENT), a.ws + WS_WGU, (size_t)2048 * D, (size_t)256 * D, true, (unsigned)D);
    EpiSwiglu E{a.in[I_BGU], a.ws + WS_HID, (const float*)(a.ws + WS_ERINV), tab};
    pg8::gemm_phase<EpiSwiglu, MoeSched, true, true>(lds, (const char*)(a.ws + WS_XN2), D / 2, S, E, wave);
}
__device__ __forceinline__ void p8_fast(const Args& a, LAS unsigned char* lds, int wg, int G, int wave) {
    LAS unsigned* tab = (LAS unsigned*)(lds + TAB_OFF); moe_tables(a, tab, wave);
    MoeSched S; S.init(tab, 4, G, wg, (const u64*)(a.ws + WS_ENT), a.ws + WS_WD, (size_t)D * FF, (size_t)256 * FF, false, (unsigned)FF); S.rev = true;
    EpiDown E{a.in[I_BD], (const u64*)(a.ws + WS_ENT), tab, a.out, a.ws};
    pg8::gemm_phase<EpiDown, MoeSched, true, true>(lds, (const char*)(a.ws + WS_HID), FF / 2, S, E, wave);
}
__device__ __forceinline__ void p9_final(const Args& a, int gw, int NGW) {
    const int lane = lane_id();
    const bf16* s0 = (const bf16*)(a.ws + WS_SLOT0); const bf16* s1 = (const bf16*)(a.ws + WS_SLOT1); const bf16* s2 = (const bf16*)(a.ws + WS_SLOT2); const bf16* s3 = (const bf16*)(a.ws + WS_SLOT3);
    const f32x4* wr = (const f32x4*)a.in[I_FNW] + lane;
    constexpr int RF = 4;
    for (int row0 = gw; row0 < T; row0 += RF * NGW) {
        f32x4 v[RF][4]; v2u sa[RF][4][4];
#pragma unroll
        for (int rr = 0; rr < RF; ++rr) { int row = row0 + rr * NGW; row = row < T ? row : T - 1; const f32x4* xr = (const f32x4*)(a.out + (size_t)row * D) + lane;
#pragma unroll
            for (int j = 0; j < 4; ++j) { v[rr][j] = xr[64 * j]; const size_t o = (size_t)row * D + 4 * lane + 256 * j; sa[rr][j][0] = *(const v2u*)(s1 + o); sa[rr][j][1] = *(const v2u*)(s2 + o); sa[rr][j][2] = *(const v2u*)(s3 + o); sa[rr][j][3] = *(const v2u*)(s0 + o); } }
#pragma unroll
        for (int rr = 0; rr < RF; ++rr) { int row = row0 + rr * NGW; row = row < T ? row : T - 1; f32x4* xr = (f32x4*)(a.out + (size_t)row * D) + lane; float s = 0.f;
#pragma unroll
            for (int j = 0; j < 4; ++j) { const v2u a1 = sa[rr][j][0], a2 = sa[rr][j][1], a3 = sa[rr][j][2], a0 = sa[rr][j][3]; f32x4 t = v[rr][j];
                t[0] += (bflo(a0.x) + bflo(a1.x)) + (bflo(a2.x) + bflo(a3.x)); t[1] += (bfhi(a0.x) + bfhi(a1.x)) + (bfhi(a2.x) + bfhi(a3.x)); t[2] += (bflo(a0.y) + bflo(a1.y)) + (bflo(a2.y) + bflo(a3.y)); t[3] += (bfhi(a0.y) + bfhi(a1.y)) + (bfhi(a2.y) + bfhi(a3.y));
                v[rr][j] = t; s += (t[0] * t[0] + t[1] * t[1]) + (t[2] * t[2] + t[3] * t[3]); }
            const float rinv = 1.0f / sqrtf(wave_sum(s) * (1.f / D) + EPS);
            if (row0 + rr * NGW < T) {
#pragma unroll
                for (int j = 0; j < 4; ++j) { const f32x4 ww = wr[64 * j]; xr[64 * j] = v[rr][j] * rinv * ww; } } }
    }
}

constexpr int NPHASES = 12;
__global__ void __launch_bounds__(NTHREADS, 2) fwd(Args a) {
    extern __shared__ __attribute__((aligned(16))) unsigned char lds_raw[];
    LAS unsigned char* lds = (LAS unsigned char*)lds_raw;
    const int wave = __builtin_amdgcn_readfirstlane((int)threadIdx.x >> 6);
    const int G = gridDim.x, wg = blockIdx.x, gw = wg * NWAVES + wave, NGW = G * NWAVES;
    volatile LAS unsigned* misc = (volatile LAS unsigned*)(lds + LDS_BYTES - 64);
    if (wave == 0 && lane_id() < 16) misc[lane_id()] = 0u;
    __syncthreads();
    XcdBarrier bar; bar.bar = (unsigned*)(a.ws + WS_CTL) + CW_BAR; bar.x = 0; bar.st = nullptr; bar.wave = wave;
    if (N_LAUNCHES == 1) bar = xcd_barrier_post((unsigned*)(a.ws + WS_CTL) + CW_BAR, misc, wave);
    const int lo = a.ph_lo, hi = a.ph_hi;
#define IN(k) (lo <= (k) && (k) < hi)
#define SEAM(k) do { if (IN(k) && IN((k) + 1)) { if (N_LAUNCHES == 1) xcd_barrier(bar); } } while (0)
    if (IN(0)) { p0_weights<false>(a, lds, gw, NGW, wave); p0_rows_fast(a, lds, gw, NGW, wave); }
    SEAM(0);
    if (IN(1)) {
        if ((wg >> 3) & 1) { p1_fast(a, lds, wg, G, wave); p0_weights<true>(a, lds, gw, NGW, wave); } else { p0_weights<true>(a, lds, gw, NGW, wave); __syncthreads(); p1_fast(a, lds, wg, G, wave); } }
    SEAM(1);
    if (IN(2)) {
        if ((wg >> 3) & 1) { sc_phase(a, gw, NGW); ssd_state_phase(a, lds, wg, G, wave); } else { ssd_state_phase(a, lds, wg, G, wave); sc_phase(a, gw, NGW); } }
    SEAM(2);
    if (IN(3)) ssd_scan_phase(a, wg, G, wave);
    SEAM(3);
    if (IN(4)) ssd_out_phase(a, lds, wg, G, wave);
    SEAM(4);
    if (IN(5)) p5_fast(a, lds, wg, G, wave);
    SEAM(5);
    if (IN(6)) p6_fast(a, lds, wg, G, wave);
    SEAM(6);
    if (IN(7)) p7_fast(a, lds, wg, G, wave);
    SEAM(7);
    if (IN(8)) p8_fast(a, lds, wg, G, wave);
    SEAM(8);
    if (IN(9)) p9_final(a, gw, NGW);
#undef IN
#undef SEAM
}

extern "C" void kernel_launch(void* const* d_in, const int* in_sizes, int n_in, void* d_out, int out_size, void* d_ws, size_t ws_size, hipStream_t stream) {
    static int grid = 0;
    if (grid == 0) {
        if (n_in != 20 || in_sizes[0] != T * D || out_size != T * D || ws_size < WS_END) { fprintf(stderr, "kernel_launch: unexpected shapes (n_in %d, in0 %d, out %d, ws %zu)\n", n_in, n_in > 0 ? in_sizes[0] : -1, out_size, ws_size); grid = -1; return; }
        int dev = 0, cus = 0, per_cu = 0;
        if (hipGetDevice(&dev) != hipSuccess || hipDeviceGetAttribute(&cus, hipDeviceAttributeMultiprocessorCount, dev) != hipSuccess) { grid = -1; return; }
        if (hipFuncSetAttribute((const void*)fwd, hipFuncAttributeMaxDynamicSharedMemorySize, LDS_BYTES) != hipSuccess) { fprintf(stderr, "kernel_launch: hipFuncSetAttribute failed\n"); grid = -1; return; }
        if (hipOccupancyMaxActiveBlocksPerMultiprocessor(&per_cu, (const void*)fwd, NTHREADS, LDS_BYTES) != hipSuccess || per_cu < 1) fprintf(stderr, "kernel_launch: occupancy query reports %d\n", per_cu);
        (void)hipGetLastError();
        grid = cus;
    }
    if (grid < 0) return;
    (void)hipMemsetAsync((char*)d_ws + WS_CTL, 0, CTL_ZERO_BYTES, stream);
    Args a{};
    for (int i = 0; i < 20; ++i) a.in[i] = (const float*)d_in[i];
    a.out = (float*)d_out; a.ws = (unsigned char*)d_ws;
    if (N_LAUNCHES == 1) { a.ph_lo = 0; a.ph_hi = NPHASES; hipLaunchKernelGGL(fwd, dim3(grid), dim3(NTHREADS), LDS_BYTES, stream, a); }
    else for (int p = 0; p < 10; ++p) { a.ph_lo = p; a.ph_hi = p + 1; hipLaunchKernelGGL(fwd, dim3(grid), dim3(NTHREADS), LDS_BYTES, stream, a); }
}
```

```cpp
#include <hip/hip_runtime.h>
#include <cstdio>
#include <cstdint>

#ifndef FAST
#define FAST 0x1FF
#endif
#ifndef N_LAUNCHES
#define N_LAUNCHES 1
#endif

#define GAS __attribute__((address_space(1)))
#define LAS __attribute__((address_space(3)))
typedef unsigned short bf16;
typedef unsigned v4u __attribute__((ext_vector_type(4)));
typedef unsigned v2u __attribute__((ext_vector_type(2)));
typedef unsigned long long u64;
typedef float f32x4 __attribute__((ext_vector_type(4)));
typedef float f32x2 __attribute__((ext_vector_type(2)));
typedef short bf16x8 __attribute__((ext_vector_type(8)));

constexpr int D = 1024, NBATCH = 8, SEQ = 8192, T = NBATCH * SEQ;
constexpr int NH = 16, HD = 64, NG = 2, HPG = 8, DST = 128, CHK = 128, NCHK = SEQ / CHK;
constexpr int DXBC = 1536, NPROJ = 5632, PROJ_DIM = 5648, DT_COL0 = 2560;
constexpr int NE = 32, FF = 1024;
constexpr float EPS = 1e-5f, SWI_LIMIT = 7.0f, SWI_ALPHA = 1.702f;
constexpr int XN_LD = 1088, WIN_LD = 1088, G2_LD = 2112, WOUT_LD = 2112;
constexpr int ENT_CAP = 65536;
constexpr int HID_ROWS = 270336;
enum { I_X = 0, I_N1W, I_WIN, I_SCW, I_SCB, I_DTB, I_ALOG, I_DSKIP, I_SNW, I_SCCW, I_SCNW, I_WOUT, I_N2W, I_WR, I_BR, I_WGU, I_BGU, I_WD, I_BD, I_FNW };

constexpr size_t MiB = 1u << 20;
constexpr size_t WS_CTL = 0, CTL_ZERO_BYTES = 1 * MiB;
constexpr size_t WS_DT = 1 * MiB;
constexpr size_t WS_CDEC = 5 * MiB;
constexpr size_t WS_RINV = 5 * MiB + 512 * 1024;
constexpr size_t WS_WIN = 6 * MiB;
constexpr size_t WS_WOUT = 18 * MiB;
constexpr size_t WS_ENT = 23 * MiB;
constexpr size_t WS_WD = 40 * MiB;
constexpr size_t WS_WGU = 104 * MiB;
constexpr size_t WS_Z = 232 * MiB;
constexpr size_t WS_XBC = 360 * MiB;
constexpr size_t WS_G2 = 552 * MiB;
constexpr size_t WS_U = 816 * MiB;
constexpr size_t WS_XN2 = 232 * MiB;
constexpr size_t WS_HID = 360 * MiB;
constexpr size_t SLOT_SKEW = 1 * MiB + 68 * 1024 + 256;
constexpr size_t WS_SLOT0 = 624 * MiB, WS_SLOT1 = 72 * MiB + SLOT_SKEW, WS_SLOT2 = 200 * MiB + 2 * SLOT_SKEW, WS_SLOT3 = 752 * MiB + 3 * SLOT_SKEW;
constexpr size_t WS_END = 1016 * MiB;
constexpr size_t WS_ERINV = WS_WIN;
static_assert((size_t)NE * ENT_CAP * 4 <= (size_t)NPROJ * WIN_LD * 2, "erinv fits in the dead in-projection weights");
static_assert(WS_WIN + (size_t)NPROJ * WIN_LD * 2 <= WS_WOUT && WS_WOUT + (size_t)D * WOUT_LD * 2 <= WS_ENT && WS_ENT + (size_t)NE * ENT_CAP * 8 <= WS_WD && WS_G2 + (size_t)T * G2_LD * 2 <= WS_U && WS_U + (size_t)T * D * 2 <= WS_END && (size_t)T * XN_LD * 2 <= 256 * MiB, "padded layout");
static_assert(WS_HID + (size_t)HID_ROWS * FF <= WS_SLOT0 && WS_SLOT0 + (size_t)T * D * 2 <= WS_SLOT3 && WS_SLOT3 + (size_t)T * D * 2 <= WS_END, "slot 0 sits between the fp8 hid buffer and slot 3");
static_assert(WS_WD + (size_t)NE * D * FF <= WS_SLOT1 && WS_SLOT1 + (size_t)T * D * 2 <= WS_SLOT2 && WS_SLOT2 + (size_t)T * D * 2 <= WS_HID, "slots 1, 2 sit between the fp8 down weights and the hid buffer");
constexpr size_t DO_XN = 0;
constexpr size_t DO_S = 128 * MiB;
constexpr size_t DO_XC = 0;
constexpr int CW_BAR = 0, CW_GCOUNT = 4096;

constexpr int NWAVES = 8, NTHREADS = 512;
constexpr int LDS_BYTES = 160 * 1024;

struct Args { const float* in[20]; float* out; unsigned char* ws; int ph_lo, ph_hi, pad0, pad1; };

__device__ __forceinline__ unsigned f2bf(float f) { unsigned u = __builtin_bit_cast(unsigned, f); return (u + 0x7fffu + ((u >> 16) & 1u)) >> 16; }
__device__ __forceinline__ unsigned pk2(float lo, float hi) { return f2bf(lo) | (f2bf(hi) << 16); }
__device__ __forceinline__ unsigned pk2_hw(float lo, float hi) { return pk2(lo, hi); }
__device__ __forceinline__ float bflo(unsigned w) { return __builtin_bit_cast(float, w << 16); }
__device__ __forceinline__ float bfhi(unsigned w) { return __builtin_bit_cast(float, w & 0xffff0000u); }
__device__ __forceinline__ float bf2f(bf16 b) { return __builtin_bit_cast(float, ((unsigned)b) << 16); }
__device__ __forceinline__ float wave_sum(float v) {
#pragma unroll
    for (int o = 1; o < 64; o <<= 1) v += __shfl_xor(v, o);
    return v;
}
__device__ __forceinline__ float silu_f(float x) { return x / (1.0f + __expf(-x)); }
__device__ __forceinline__ float silu_fast(float x) { return x * __builtin_amdgcn_rcpf(1.0f + __builtin_amdgcn_exp2f(x * -1.44269504f)); }
__device__ __forceinline__ float softplus_f(float x) { return fmaxf(x, 0.0f) + log1pf(expf(-fabsf(x))); }
__device__ __forceinline__ int lane_id() { return (int)__builtin_amdgcn_mbcnt_hi(~0u, __builtin_amdgcn_mbcnt_lo(~0u, 0u)); }
__device__ __forceinline__ int lane_id_v() { int l; asm volatile("v_mbcnt_lo_u32_b32 %0, -1, 0\n\tv_mbcnt_hi_u32_b32 %0, -1, %0" : "=v"(l)); return l; }
__device__ __forceinline__ float bperm(float v, int src) { return __builtin_bit_cast(float, __builtin_amdgcn_ds_bpermute(src << 2, __builtin_bit_cast(int, v))); }
#define LDS_WAIT() asm volatile("s_waitcnt lgkmcnt(0)" ::: "memory")
#define VM_WAIT() asm volatile("s_waitcnt vmcnt(0)" ::: "memory")

#define XB_TMO      128
#define XB_XCNT(j)  (256  + 64 * (j))
#define XB_XSUB(j)  (1280 + 64 * (j))
#define XB_XGEN(j)  (2304 + 64 * (j))
#define XB_TOP      3328
#define XB_TOPGEN   3392
#define XCD_BAR_WORDS 3456
#define XB_SPIN_CAP (1u << 18)
__device__ __forceinline__ unsigned xb_ld(unsigned* p)              { return __hip_atomic_load(p, __ATOMIC_RELAXED, __HIP_MEMORY_SCOPE_AGENT); }
__device__ __forceinline__ unsigned xb_add(unsigned* p, unsigned v) { return __hip_atomic_fetch_add(p, v, __ATOMIC_RELAXED, __HIP_MEMORY_SCOPE_AGENT); }
__device__ __forceinline__ unsigned xb_xcc_id() { return (unsigned)__builtin_amdgcn_s_getreg((3 << 11) | 20) & 0xFu; }
#define XB_SPIN(cond, bar) do { unsigned _sp = 0; while (cond) { __builtin_amdgcn_s_sleep(1); \
    if ((++_sp & 255u) == 0u) { if (xb_ld(&(bar)[XB_TMO])) break; if (_sp > XB_SPIN_CAP) { atomicAdd(&(bar)[XB_TMO], 1u); break; } } } } while (0)
struct XcdBarrier { unsigned* bar; unsigned x; volatile LAS unsigned* st; int wave; };
__device__ __forceinline__ XcdBarrier xcd_barrier_post(unsigned* bar, volatile LAS unsigned* st, int wave) {
    XcdBarrier b; b.bar = bar; b.x = xb_xcc_id(); b.st = st; b.wave = wave;
    if (wave == 0 && lane_id() == 0) (void)xb_add(&bar[XB_XCNT(b.x)], 1u);
    return b;
}
__device__ __forceinline__ void xcd_barrier_complete(unsigned* bar, unsigned x, unsigned& nloc, unsigned& nx) {
    const unsigned G = gridDim.x * gridDim.y * gridDim.z;
    unsigned sum, cnt, mine, sp = 0u;
    for (;;) {
        sum = 0u; cnt = 0u; mine = 0u;
#pragma unroll
        for (unsigned j = 0; j < 16; ++j) { const unsigned c = xb_ld(&bar[XB_XCNT(j)]); sum += c; cnt += (c > 0u) ? 1u : 0u; mine = (j == x) ? c : mine; }
        if (sum == G) break;
        __builtin_amdgcn_s_sleep(1);
        if ((++sp & 255u) == 0u) { if (xb_ld(&bar[XB_TMO])) break; if (sp > XB_SPIN_CAP) { atomicAdd(&bar[XB_TMO], 1u); break; } }
    }
    nloc = mine > 0u ? mine : 1u; nx = cnt > 0u ? cnt : 1u;
}
__device__ __forceinline__ void xcd_barrier(const XcdBarrier& b) {
    asm volatile("s_waitcnt vmcnt(0)" ::: "memory");
    __syncthreads();
    if (b.wave == 0 && lane_id() == 0) {
        unsigned* bar = b.bar;
        __builtin_amdgcn_s_waitcnt(0);
        unsigned nloc = b.st[0], nx = b.st[1];
        if (nloc == 0u) { xcd_barrier_complete(bar, b.x, nloc, nx); b.st[0] = nloc; b.st[1] = nx; }
        const unsigned old = xb_add(&bar[XB_XSUB(b.x)], 1u);
        const unsigned gen = old / nloc;
        if (old + 1u == (gen + 1u) * nloc) {
            __builtin_amdgcn_fence(__ATOMIC_RELEASE, "agent");
            asm volatile("s_waitcnt vmcnt(0)" ::: "memory");
            const unsigned og = xb_add(&bar[XB_TOP], 1u);
            const unsigned tg = og / nx;
            if (og + 1u == (tg + 1u) * nx) xb_add(&bar[XB_TOPGEN], 1u);
            else XB_SPIN(xb_ld(&bar[XB_TOPGEN]) == tg, bar);
            __builtin_amdgcn_fence(__ATOMIC_ACQUIRE, "agent");
            xb_add(&bar[XB_XGEN(b.x)], 1u);
            asm volatile("s_waitcnt vmcnt(0)" ::: "memory");
        } else {
            XB_SPIN(xb_ld(&bar[XB_XGEN(b.x)]) == gen, bar);
            __builtin_amdgcn_fence(__ATOMIC_ACQUIRE, "agent");
            asm volatile("s_waitcnt vmcnt(0)" ::: "memory");
        }
    }
    __syncthreads();
}

__device__ __forceinline__ void p0_transpose_item(const float* W, int ldsrc, int ksrc0, int nsrc0, bf16* WT, int lddst, int ndst0, int kdst0, LAS float* scr, int lane) {
#pragma unroll 8
    for (int i = 0; i < 32; ++i) { const int kk = 2 * i + (lane >> 5); scr[kk * 33 + (lane & 31)] = W[(size_t)(ksrc0 + kk) * ldsrc + nsrc0 + (lane & 31)]; }
    LDS_WAIT(); asm volatile("" ::: "memory");
    const int c = lane & 7;
#pragma unroll
    for (int j = 0; j < 4; ++j) { const int n = (lane >> 3) + 8 * j; const LAS float* s = scr + (8 * c) * 33 + n;
        v4u o; o.x = pk2(s[0 * 33], s[1 * 33]); o.y = pk2(s[2 * 33], s[3 * 33]); o.z = pk2(s[4 * 33], s[5 * 33]); o.w = pk2(s[6 * 33], s[7 * 33]);
        *(v4u*)(WT + (size_t)(ndst0 + n) * lddst + kdst0 + 8 * c) = o; }
    LDS_WAIT(); asm volatile("" ::: "memory");
}
__device__ __forceinline__ unsigned pk4_fp8(float a, float b, float c, float d);

__device__ __forceinline__ void p0_transpose_item8(const float* W, int ldsrc, int ksrc0, int nsrc0, unsigned char* WT, int lddst, int ndst0, int kdst0, LAS float* scr, int lane) {
#pragma unroll 8
    for (int i = 0; i < 32; ++i) { const int kk = 2 * i + (lane >> 5); scr[kk * 33 + (lane & 31)] = W[(size_t)(ksrc0 + kk) * ldsrc + nsrc0 + (lane & 31)]; }
    LDS_WAIT(); asm volatile("" ::: "memory");
    const int c = lane & 3;
#pragma unroll
    for (int j = 0; j < 2; ++j) { const int n = (lane >> 2) + 16 * j; const LAS float* sp = scr + (16 * c) * 33 + n;
        v4u o; o.x = pk4_fp8(sp[0 * 33] * 32.f, sp[1 * 33] * 32.f, sp[2 * 33] * 32.f, sp[3 * 33] * 32.f); o.y = pk4_fp8(sp[4 * 33] * 32.f, sp[5 * 33] * 32.f, sp[6 * 33] * 32.f, sp[7 * 33] * 32.f);
        o.z = pk4_fp8(sp[8 * 33] * 32.f, sp[9 * 33] * 32.f, sp[10 * 33] * 32.f, sp[11 * 33] * 32.f); o.w = pk4_fp8(sp[12 * 33] * 32.f, sp[13 * 33] * 32.f, sp[14 * 33] * 32.f, sp[15 * 33] * 32.f);
        *(v4u*)(WT + (size_t)(ndst0 + n) * lddst + kdst0 + 16 * c) = o; }
    LDS_WAIT(); asm volatile("" ::: "memory");
}
struct TItem { const float* W; unsigned char* WT; int ldsrc, ksrc0, nsrc0, lddst, ndst0, kdst0, f8; };
__device__ __forceinline__ TItem p0_decode(const Args& a, int it) {
    unsigned char* ws = a.ws; TItem t;
    constexpr int I_IN = 8 * (NPROJ / 64), I_OUT = 16 * 16, I_GU = 8 * 32, I_DN = 8 * 16;
    int r = it;
    if (r < I_IN) { const int kb = r / (NPROJ / 64), nb = r % (NPROJ / 64), nd = 64 * nb;
        int ns = nd < DT_COL0 ? nd : nd + 16;
        if (nd >= 3584) { const int tt = (nd - 3584) >> 8, cc = (nd - 3584) & 255; ns = 16 + (cc < 128 ? 3584 + 128 * tt + cc : 4608 + 128 * tt + (cc - 128)); }
        t = TItem{a.in[I_WIN], ws + WS_WIN, PROJ_DIM, 128 * kb, ns, WIN_LD * 2, nd, 128 * kb * 2, 0}; return t; }
    r -= I_IN;
    if (r < I_OUT) { const int kb = r / 16, nb = r % 16, kd = 128 * kb, ks = (kd + 1024) & 2047;
        t = TItem{a.in[I_WOUT], ws + WS_WOUT, D, ks, 64 * nb, WOUT_LD * 2, 64 * nb, kd * 2, 0}; return t; }
    r -= I_OUT;
    if (r < NE * I_GU) { const int e = r / I_GU, q = r % I_GU, kb = q / 32, nb = q % 32, nd = 64 * nb;
        const int pn = nd >> 8, bj = (nd >> 7) & 1, cc = nd & 127, ns = bj * 1024 + 128 * pn + cc;
        t = TItem{a.in[I_WGU] + (size_t)e * D * 2048, ws + WS_WGU + (size_t)e * 2048 * D, 2048, 128 * kb, ns, D, nd, 128 * kb, 1}; return t; }
    r -= NE * I_GU;
    { const int e = r / I_DN, q = r % I_DN, kb = q / 16, nb = q % 16;
        t = TItem{a.in[I_WD] + (size_t)e * FF * D, ws + WS_WD + (size_t)e * D * FF, D, 128 * kb, 64 * nb, FF, 64 * nb, 128 * kb, 1}; return t; }
}
constexpr int P0_ITEMS_PROJ = 8 * (NPROJ / 64) + 16 * 16;
template <bool MOE>
__device__ __forceinline__ void p0_weights(const Args& a, LAS unsigned char* lds, int gw, int NGW, int wave) {
    const int lane = lane_id_v(), c = lane & 15, h = lane >> 4;
    LAS unsigned char* scr = lds + wave * 16384;
    constexpr int NITEMS = 8 * (NPROJ / 64) + 16 * 16 + NE * 8 * 32 + NE * 8 * 16;
    __syncthreads();
    for (int it = (MOE ? P0_ITEMS_PROJ : 0) + gw; it < (MOE ? NITEMS : P0_ITEMS_PROJ); it += NGW) {
        const TItem t = p0_decode(a, it);
        const float* src = t.W + (size_t)(t.ksrc0 + 4 * h) * t.ldsrc + t.nsrc0 + 4 * c;
        f32x4 v[32];
#pragma unroll
        for (int g = 0; g < 8; ++g)
#pragma unroll
            for (int r = 0; r < 4; ++r) v[4 * g + r] = *(const f32x4*)(src + (size_t)(16 * g + r) * t.ldsrc);
        if (t.f8) {
#pragma unroll
            for (int g = 0; g < 8; ++g)
#pragma unroll
                for (int j = 0; j < 4; ++j)
                    *(LAS unsigned*)(scr + (4 * c + j) * 144 + 16 * g + 4 * h) = pk4_fp8(v[4 * g][j] * 32.f, v[4 * g + 1][j] * 32.f, v[4 * g + 2][j] * 32.f, v[4 * g + 3][j] * 32.f);
            LDS_WAIT(); asm volatile("" ::: "memory");
#pragma unroll
            for (int q = 0; q < 8; ++q) { const int n = 8 * q + (lane >> 3), ch = lane & 7;
                *(v4u*)(t.WT + (size_t)(t.ndst0 + n) * t.lddst + t.kdst0 + 16 * ch) = *(const LAS v4u*)(scr + n * 144 + 16 * ch); }
        } else {
#pragma unroll
            for (int g = 0; g < 8; ++g)
#pragma unroll
                for (int j = 0; j < 4; ++j) { v2u w; w.x = pk2(v[4 * g][j], v[4 * g + 1][j]); w.y = pk2(v[4 * g + 2][j], v[4 * g + 3][j]);
                    *(LAS v2u*)(scr + (4 * c + j) * 256 + 32 * g + 8 * h) = w; }
            LDS_WAIT(); asm volatile("" ::: "memory");
#pragma unroll
            for (int q = 0; q < 16; ++q) { const int n = 4 * q + (lane >> 4), ch = lane & 15;
                *(v4u*)(t.WT + (size_t)(t.ndst0 + n) * t.lddst + t.kdst0 + 16 * ch) = *(const LAS v4u*)(scr + n * 256 + 16 * ch); }
        }
        LDS_WAIT(); asm volatile("" ::: "memory");
    }
}
__device__ __forceinline__ void rms_row_to_bf16(const float* xrow, const float* w, bf16* orow, int lane) {
    const f32x4* xr = (const f32x4*)xrow + lane; const f32x4* wr = (const f32x4*)w + lane;
    f32x4 v[4]; float s = 0.f;
#pragma unroll
    for (int j = 0; j < 4; ++j) { v[j] = xr[64 * j]; s += (v[j].x * v[j].x + v[j].y * v[j].y) + (v[j].z * v[j].z + v[j].w * v[j].w); }
    const float rinv = 1.0f / sqrtf(wave_sum(s) * (1.f / D) + EPS);
    v2u* o8 = (v2u*)orow + lane;
#pragma unroll
    for (int j = 0; j < 4; ++j) { const f32x4 ww = wr[64 * j]; v2u o; o.x = pk2(v[j].x * rinv * ww.x, v[j].y * rinv * ww.y); o.y = pk2(v[j].z * rinv * ww.z, v[j].w * rinv * ww.w); o8[64 * j] = o; }
}
__device__ __forceinline__ void p0_dt_slow(const Args& a, int wg, int G) {
    const int tid = threadIdx.x, rl = tid >> 4, hd = tid & 15;
    const float* x = a.in[I_X]; const float* nw = a.in[I_N1W]; const float* win = a.in[I_WIN] + DT_COL0 + hd;
    float* dt = (float*)(a.ws + WS_DT);
    for (int r0 = wg * 32; r0 < T; r0 += G * 32) {
        const int row = r0 + rl; const float* xr = x + (size_t)row * D;
        float s = 0.f, d = 0.f;
        for (int k = 0; k < D; ++k) { const float xv = xr[k]; s += xv * xv; d += xv * nw[k] * win[(size_t)k * PROJ_DIM]; }
        const float rinv = 1.0f / sqrtf(s * (1.f / D) + EPS);
        dt[row * 16 + hd] = softplus_f(d * rinv + a.in[I_DTB][hd]);
    }
}

constexpr int SG_LD = 132;
template <class ARow>
__device__ __forceinline__ void sg_tile(LAS float* As, LAS float* Bs, const ARow& arow, const bf16* Bt, int ldb, int K, float (&acc)[8][4]) {
    const int t = threadIdx.x, tm = t >> 5, tn = t & 31, lr = t >> 2, kq = t & 3;
    const bf16* ap = arow(lr) + 8 * kq;
    const bf16* bp = Bt + (size_t)lr * ldb + 8 * kq;
#pragma unroll
    for (int i = 0; i < 8; ++i)
#pragma unroll
        for (int j = 0; j < 4; ++j) acc[i][j] = 0.f;
    for (int k0 = 0; k0 < K; k0 += 32) {
        const v4u av = *(const v4u*)(ap + k0), bv = *(const v4u*)(bp + k0);
        __syncthreads();
        { LAS float* pa = As + (8 * kq) * SG_LD + lr; LAS float* pb = Bs + (8 * kq) * SG_LD + lr;
          pa[0 * SG_LD] = bflo(av.x); pa[1 * SG_LD] = bfhi(av.x); pa[2 * SG_LD] = bflo(av.y); pa[3 * SG_LD] = bfhi(av.y);
          pa[4 * SG_LD] = bflo(av.z); pa[5 * SG_LD] = bfhi(av.z); pa[6 * SG_LD] = bflo(av.w); pa[7 * SG_LD] = bfhi(av.w);
          pb[0 * SG_LD] = bflo(bv.x); pb[1 * SG_LD] = bfhi(bv.x); pb[2 * SG_LD] = bflo(bv.y); pb[3 * SG_LD] = bfhi(bv.y);
          pb[4 * SG_LD] = bflo(bv.z); pb[5 * SG_LD] = bfhi(bv.z); pb[6 * SG_LD] = bflo(bv.w); pb[7 * SG_LD] = bfhi(bv.w); }
        __syncthreads();
#pragma unroll 8
        for (int kk = 0; kk < 32; ++kk) {
            const f32x4 a0 = *(const LAS f32x4*)(As + kk * SG_LD + 8 * tm), a1 = *(const LAS f32x4*)(As + kk * SG_LD + 8 * tm + 4);
            const f32x4 b = *(const LAS f32x4*)(Bs + kk * SG_LD + 4 * tn);
            const float av8[8] = {a0.x, a0.y, a0.z, a0.w, a1.x, a1.y, a1.z, a1.w};
#pragma unroll
            for (int i = 0; i < 8; ++i) { acc[i][0] += av8[i] * b.x; acc[i][1] += av8[i] * b.y; acc[i][2] += av8[i] * b.z; acc[i][3] += av8[i] * b.w; }
        }
    }
    __syncthreads();
}

namespace pg8 {
constexpr int BM = 256, BK = 64, HALF = 128, HTB = HALF * BK * 2, STAGE_BYTES = 8 * HTB;
__device__ __forceinline__ int lds_byte(int r, int c) { const int st = (r >> 4) * 2 + (c >> 5), rr = r & 15, cc = c & 31, ob = rr * 64 + cc * 2; return st * 1024 + (ob ^ (((ob >> 9) & 1) << 5)); }
__device__ __forceinline__ void stage_rc(int b, int& R, int& C) { const int st = b / 1024, sb = b % 1024, swz = sb ^ (((sb >> 9) & 1) << 5); R = (st >> 1) * 16 + swz / 64; C = (st & 1) * 32 + (swz % 64) / 2; }
__device__ __forceinline__ int perm32(int rho) { const int n = rho >> 4, i = rho & 15; return 8 * (i >> 2) + 4 * n + (i & 3); }
struct Unit { int pm, pn, aux; };
typedef int v8i __attribute__((ext_vector_type(8)));
typedef int v4i __attribute__((ext_vector_type(4)));
template <class Epi, class Sched, bool ALIGN_EPI, bool F8 = false>
__device__ __forceinline__ void gemm_phase(LAS unsigned char* lds, const char* Abase, const int K, const Sched& S, const Epi& E, const int wid) {
    const int lane = lane_id(), tid = wid * 64 + lane, wr = wid >> 2, wc = wid & 3, fr = lane & 15, fq = lane >> 4;
    const int nt = K / BK;
    unsigned voffB[2];
#pragma unroll
    for (int i = 0; i < 2; ++i) { int R_, C_; stage_rc(tid * 16 + i * 8192, R_, C_); const int Rb = Epi::PERM ? ((R_ & ~31) + perm32(R_ & 31)) : R_; voffB[i] = (unsigned)Rb * S.ldbB + (unsigned)C_ * 2u; }
    const size_t kstep = (size_t)(BK * 2), hstepB = (size_t)HALF * S.ldbB;
    const unsigned ldsw = (unsigned)wid * 1024u;
    const int aoff = lds_byte(wr * 64 + fr, fq * 8), boff = lds_byte(wc * 32 + fr, fq * 8);
#define PG8_SA(b, h) (((b) * 2 + (h)) * HTB)
#define PG8_SB(b, h) ((4 + (b) * 2 + (h)) * HTB)
#define PG8_STAGE(bufoff, gbase, voff) do { _Pragma("unroll") for (int _i = 0; _i < 2; ++_i) \
        __builtin_amdgcn_global_load_lds((const unsigned*)((const char*)(gbase) + (voff)[_i]), (LAS unsigned*)(lds + (bufoff) + ldsw + _i * 8192), 16, 0, 0); } while (0)
#define PG8_LDA(dst, b, h) do { _Pragma("unroll") for (int m = 0; m < 4; ++m) { if constexpr (F8) { dst##8[m].lo = *(const LAS v4i*)(lds + PG8_SA(b, h) + aoff + m * 2048); dst##8[m].hi = *(const LAS v4i*)(lds + PG8_SA(b, h) + aoff + m * 2048 + 1024); } \
        else { _Pragma("unroll") for (int k = 0; k < 2; ++k) dst[m][k] = *(const LAS bf16x8*)(lds + PG8_SA(b, h) + aoff + m * 2048 + k * 1024); } } } while (0)
#define PG8_LDB(dst, b, h) do { _Pragma("unroll") for (int n = 0; n < 2; ++n) { if constexpr (F8) { dst##8[n].lo = *(const LAS v4i*)(lds + PG8_SB(b, h) + boff + n * 2048); dst##8[n].hi = *(const LAS v4i*)(lds + PG8_SB(b, h) + boff + n * 2048 + 1024); } \
        else { _Pragma("unroll") for (int k = 0; k < 2; ++k) dst[n][k] = *(const LAS bf16x8*)(lds + PG8_SB(b, h) + boff + n * 2048 + k * 1024); } } } while (0)
#define PG8_MMA(ai, bj, At, Bt) do { __builtin_amdgcn_s_setprio(1); _Pragma("unroll") for (int m = 0; m < 4; ++m) _Pragma("unroll") for (int n = 0; n < 2; ++n) { \
        if constexpr (F8) asm volatile("v_mfma_scale_f32_16x16x128_f8f6f4 %0, %1, %2, %0, %3, %3 op_sel_hi:[0,0,0]" : "+v"(acc[ai][bj][m][n]) : "v"(Bt##8[n]), "v"(At##8[m]), "v"(one_scale));   \
        else { _Pragma("unroll") for (int k = 0; k < 2; ++k) acc[ai][bj][m][n] = __builtin_amdgcn_mfma_f32_16x16x32_bf16(Bt[n][k], At[m][k], acc[ai][bj][m][n], 0, 0, 0); } } \
        __builtin_amdgcn_s_setprio(0); } while (0)
#define PG8_WAIT_V(n) asm volatile("s_waitcnt vmcnt(" #n ")" ::: "memory")
#define PG8_WAIT_L(n) asm volatile("s_waitcnt lgkmcnt(" #n ")" ::: "memory")
#define PG8_WAIT_V8S do { if (post_epi) asm volatile("s_waitcnt vmcnt(%0)" :: "n"(8 + Epi::NST) : "memory"); else asm volatile("s_waitcnt vmcnt(8)" ::: "memory"); } while (0)
#define PG8_BAR __builtin_amdgcn_s_barrier()
#define PG8_SCHED __builtin_amdgcn_sched_barrier(0)
    Unit cur, nxt; int ui = 0;
    if (!S.next(0, cur)) return;
    f32x4 acc[2][2][4][2];
#pragma unroll
    for (int a = 0; a < 2; ++a)
#pragma unroll
        for (int b = 0; b < 2; ++b)
#pragma unroll
            for (int m = 0; m < 4; ++m)
#pragma unroll
                for (int n = 0; n < 2; ++n) acc[a][b][m][n] = (f32x4){0.f, 0.f, 0.f, 0.f};
    bf16x8 At[4][2], B0[2][2], B1[2][2]; v8i At8[4], B08[2], B18[2]; const int one_scale = 0x7f7f7f7f;
    unsigned cA0[2], cA1[2], nA0[2], nA1[2];
    S.a_offs(cur, tid, cA0, cA1);
    const char* cB = S.b_base(cur);
    PG8_STAGE(PG8_SB(0, 0), cB, voffB); PG8_STAGE(PG8_SB(0, 1), cB + hstepB, voffB); PG8_STAGE(PG8_SA(0, 0), Abase, cA0); PG8_STAGE(PG8_SA(0, 1), Abase, cA1);
    if (wr == 1) PG8_BAR;
    PG8_WAIT_V(2); PG8_BAR;
    PG8_STAGE(PG8_SB(1, 0), cB + kstep, voffB); PG8_STAGE(PG8_SA(1, 0), Abase + kstep, cA0); PG8_STAGE(PG8_SB(1, 1), cB + hstepB + kstep, voffB);
    PG8_WAIT_V(6); PG8_BAR;
    for (;;) {
        const bool has_next = S.next(ui + 1, nxt);
        const char* nB = cB;
        if (has_next) { S.a_offs(nxt, tid, nA0, nA1); nB = S.b_base(nxt); } else { nA0[0] = cA0[0]; nA0[1] = cA0[1]; nA1[0] = cA1[0]; nA1[1] = cA1[1]; }
#pragma unroll 1
        for (int t = 0; t < nt; t += 2) {
            const bool last = (t == nt - 2);
            const bool post_epi = (t == 0) && (ui > 0);
            if (last) E.dma(cur, lds + 135168, wid, tid & 63);
            const char* a1 = Abase + (size_t)(t + 1) * kstep;
            const char* a2 = last ? Abase : Abase + (size_t)(t + 2) * kstep; const char* b2 = last ? nB : cB + (size_t)(t + 2) * kstep;
            const char* a3 = a2 + kstep; const char* b3 = b2 + kstep;
            unsigned x0[2], x1[2];
            x0[0] = last ? nA0[0] : cA0[0]; x0[1] = last ? nA0[1] : cA0[1]; x1[0] = last ? nA1[0] : cA1[0]; x1[1] = last ? nA1[1] : cA1[1];
            PG8_LDB(B0, 0, 0); PG8_LDB(B1, 0, 1); PG8_SCHED; PG8_LDA(At, 0, 0); PG8_STAGE(PG8_SA(1, 1), a1, cA1);
            PG8_WAIT_V8S; PG8_BAR; PG8_MMA(0, 0, At, B0); PG8_MMA(0, 1, At, B1); PG8_BAR; PG8_SCHED;
            PG8_LDA(At, 0, 1); PG8_STAGE(PG8_SB(0, 0), b2, voffB); PG8_STAGE(PG8_SB(0, 1), b2 + hstepB, voffB); PG8_STAGE(PG8_SA(0, 0), a2, x0);
            PG8_WAIT_V8S; PG8_BAR; PG8_MMA(1, 0, At, B0); PG8_MMA(1, 1, At, B1); PG8_BAR; PG8_SCHED;
            PG8_LDB(B0, 1, 0); PG8_LDB(B1, 1, 1); PG8_SCHED; PG8_LDA(At, 1, 0); PG8_STAGE(PG8_SA(0, 1), a2, x1);
            PG8_WAIT_V(8); PG8_BAR; PG8_MMA(0, 0, At, B0); PG8_MMA(0, 1, At, B1); PG8_BAR; PG8_SCHED;
            PG8_LDA(At, 1, 1); PG8_STAGE(PG8_SB(1, 0), b3, voffB); PG8_STAGE(PG8_SB(1, 1), b3 + hstepB, voffB); PG8_STAGE(PG8_SA(1, 0), a3, x0);
            PG8_WAIT_V(8); PG8_BAR; PG8_MMA(1, 0, At, B0); PG8_MMA(1, 1, At, B1); PG8_BAR; PG8_SCHED;
        }
        if constexpr (ALIGN_EPI) { if (wr == 0) PG8_BAR; }
        if constexpr (F8) asm volatile("s_nop 15\n\ts_nop 15" ::: "memory");
        E(acc, cur, wr, wc, fr, fq, lds + 135168);
        if (!has_next) break;
#pragma unroll
        for (int a = 0; a < 2; ++a)
#pragma unroll
            for (int b = 0; b < 2; ++b)
#pragma unroll
                for (int m = 0; m < 4; ++m)
#pragma unroll
                    for (int n = 0; n < 2; ++n) acc[a][b][m][n] = (f32x4){0.f, 0.f, 0.f, 0.f};
        cur = nxt; cB = nB; cA0[0] = nA0[0]; cA0[1] = nA0[1]; cA1[0] = nA1[0]; cA1[1] = nA1[1]; ++ui;
        if constexpr (ALIGN_EPI) { if (wr == 1) PG8_BAR; }
    }
    PG8_WAIT_V(0);
    if constexpr (!ALIGN_EPI) { if (wr == 0) PG8_BAR; }
    PG8_BAR;
#undef PG8_SA
#undef PG8_SB
#undef PG8_STAGE
#undef PG8_LDA
#undef PG8_LDB
#undef PG8_MMA
#undef PG8_WAIT_V
#undef PG8_WAIT_L
#undef PG8_WAIT_V8S
#undef PG8_BAR
#undef PG8_SCHED
}
__device__ __forceinline__ unsigned cvt_pk_bf16(float lo, float hi) { unsigned r; asm volatile("v_cvt_pk_bf16_f32 %0, %1, %2" : "=v"(r) : "v"(lo), "v"(hi)); return r; }

struct DenseSched {
    int nM, nN, nwg, G, c, GS = 8; bool rev = false; unsigned lda2, ldbB;
    __device__ __forceinline__ void init(int M, int N, int G_, int c_, int lda) { nM = M / BM; nN = N / BM; nwg = nM * nN; G = G_; c = c_; lda2 = (unsigned)lda * 2u; }
    __device__ __forceinline__ bool next(int i, Unit& u) const {
        const long L = (long)i * G + c; if (L >= nwg) return false;
        int wgid = (int)L; { const int q = nwg / 8, r = nwg % 8, xcd = wgid % 8, off = wgid / 8; wgid = (xcd < r ? xcd * (q + 1) : r * (q + 1) + (xcd - r) * q) + off; }
        if (rev) wgid = nwg - 1 - wgid;
        const int nig = GS * nN, gid = wgid / nig, fm = gid * GS, gsz = (nM - fm) < GS ? (nM - fm) : GS;
        u.pm = fm + ((wgid % nig) % gsz); u.pn = (wgid % nig) / gsz; u.aux = 0; return true;
    }
    const char* Bt; size_t tstepB;
    __device__ __forceinline__ void a_offs(const Unit& u, int tid, unsigned (&o0)[2], unsigned (&o1)[2]) const {
        int R[2], C[2]; stage_rc(tid * 16, R[0], C[0]); stage_rc(tid * 16 + 8192, R[1], C[1]);
#pragma unroll
        for (int i = 0; i < 2; ++i) { o0[i] = (unsigned)(u.pm * BM + R[i]) * lda2 + (unsigned)C[i] * 2u; o1[i] = o0[i] + 128u * lda2; }
    }
    __device__ __forceinline__ const char* b_base(const Unit& u) const { return Bt + (size_t)u.pn * tstepB; }
};
}

__device__ __forceinline__ bf16* proj_ptr(unsigned char* ws, int row, int n) {
    if (n < 1024) return (bf16*)(ws + WS_Z) + (size_t)row * 1024 + n;
    if (n < 2560) return (bf16*)(ws + WS_XBC) + (size_t)row * DXBC + (n - 1024);
    if (n < 4608) return (bf16*)(ws + WS_G2) + (size_t)row * 2048 + (n - 2560);
    return (bf16*)(ws + WS_U) + (size_t)row * 1024 + (n - 4608);
}
__device__ __forceinline__ void p1_slow(const Args& a, LAS unsigned char* lds, int wg, int G) {
    LAS float* As = (LAS float*)lds; LAS float* Bs = As + 32 * SG_LD;
    const bf16* xn = (const bf16*)((unsigned char*)a.out + DO_XN); const bf16* wt = (const bf16*)(a.ws + WS_WIN);
    const int t = threadIdx.x, tm = t >> 5, tn = t & 31;
    for (int it = wg; it < (T / 128) * (NPROJ / 128); it += G) {
        const int mt = it / (NPROJ / 128), nt = it % (NPROJ / 128);
        float acc[8][4];
        auto arow = [&](int r) { return xn + (size_t)(mt * 128 + r) * D; };
        sg_tile(As, Bs, arow, wt + (size_t)nt * 128 * D, D, D, acc);
#pragma unroll
        for (int i = 0; i < 8; ++i) { v2u o; o.x = pk2(acc[i][0], acc[i][1]); o.y = pk2(acc[i][2], acc[i][3]);
            *(v2u*)proj_ptr(a.ws, mt * 128 + 8 * tm + i, nt * 128 + 4 * tn) = o; }
    }
}

__device__ __forceinline__ void ssd_conv_slow(const Args& a, int wg, int G) {
    const bf16* xbc = (const bf16*)(a.ws + WS_XBC); bf16* xc = (bf16*)((unsigned char*)a.out + DO_XC);
    const float* cw = a.in[I_SCW]; const float* cb = a.in[I_SCB];
    for (size_t i = (size_t)wg * NTHREADS + threadIdx.x; i < (size_t)T * (DXBC / 4); i += (size_t)G * NTHREADS) {
        const int row = (int)(i / (DXBC / 4)), c = 4 * (int)(i % (DXBC / 4)), tl = row % SEQ;
        float s[4] = {cb[c], cb[c + 1], cb[c + 2], cb[c + 3]};
#pragma unroll
        for (int k = 0; k < 4; ++k) { const int tt = tl - 3 + k; if (tt < 0) continue;
            const v2u v = *(const v2u*)(xbc + (size_t)(row - 3 + k) * DXBC + c);
            s[0] += cw[k * DXBC + c] * bflo(v.x); s[1] += cw[k * DXBC + c + 1] * bfhi(v.x); s[2] += cw[k * DXBC + c + 2] * bflo(v.y); s[3] += cw[k * DXBC + c + 3] * bfhi(v.y); }
        v2u o; o.x = pk2(silu_f(s[0]), silu_f(s[1])); o.y = pk2(silu_f(s[2]), silu_f(s[3]));
        *(v2u*)(xc + (size_t)row * DXBC + c) = o;
    }
}
__device__ __forceinline__ void ssd_rec_slow(const Args& a, LAS unsigned char* lds, int wg) {
    if (wg >= NBATCH * NH) return;
    const int b = wg >> 4, h = wg & 15, g = h >> 3, tid = threadIdx.x, lane = tid & 63;
    const bf16* xc = (const bf16*)((unsigned char*)a.out + DO_XC); const float* dt = (const float*)(a.ws + WS_DT);
    bf16* g2 = (bf16*)(a.ws + WS_G2);
    LAS float* Bc = (LAS float*)lds; LAS float* Cc = Bc + 64 * 128;
    const float A = -expf(a.in[I_ALOG][h]), Dh = a.in[I_DSKIP][h];
    float st[128];
#pragma unroll
    for (int n = 0; n < 128; ++n) st[n] = 0.f;
    for (int t0 = 0; t0 < SEQ; t0 += 64) {
        __syncthreads();
        { const int tt = tid >> 3, seg = tid & 7; const size_t row = (size_t)b * SEQ + t0 + tt;
          const bf16* pb = xc + row * DXBC + 1024 + 128 * g + 16 * seg; const bf16* pc = xc + row * DXBC + 1280 + 128 * g + 16 * seg;
#pragma unroll
          for (int q = 0; q < 2; ++q) { const v4u vb = *(const v4u*)(pb + 8 * q), vc = *(const v4u*)(pc + 8 * q);
              LAS float* ob = Bc + tt * 128 + 16 * seg + 8 * q; LAS float* oc = Cc + tt * 128 + 16 * seg + 8 * q;
              ob[0] = bflo(vb.x); ob[1] = bfhi(vb.x); ob[2] = bflo(vb.y); ob[3] = bfhi(vb.y); ob[4] = bflo(vb.z); ob[5] = bfhi(vb.z); ob[6] = bflo(vb.w); ob[7] = bfhi(vb.w);
              oc[0] = bflo(vc.x); oc[1] = bfhi(vc.x); oc[2] = bflo(vc.y); oc[3] = bfhi(vc.y); oc[4] = bflo(vc.z); oc[5] = bfhi(vc.z); oc[6] = bflo(vc.w); oc[7] = bfhi(vc.w); } }
        __syncthreads();
        if (tid < 64) {
            for (int tt = 0; tt < 64; ++tt) {
                const size_t row = (size_t)b * SEQ + t0 + tt;
                const float dtv = dt[row * 16 + h], x = bf2f(xc[row * DXBC + h * 64 + lane]);
                const float dec = expf(dtv * A), xd = dtv * x; float y = 0.f;
#pragma unroll
                for (int n4 = 0; n4 < 32; ++n4) { const f32x4 bv = *(const LAS f32x4*)(Bc + tt * 128 + 4 * n4), cv = *(const LAS f32x4*)(Cc + tt * 128 + 4 * n4);
                    st[4 * n4 + 0] = st[4 * n4 + 0] * dec + xd * bv.x; y += st[4 * n4 + 0] * cv.x;
                    st[4 * n4 + 1] = st[4 * n4 + 1] * dec + xd * bv.y; y += st[4 * n4 + 1] * cv.y;
                    st[4 * n4 + 2] = st[4 * n4 + 2] * dec + xd * bv.z; y += st[4 * n4 + 2] * cv.z;
                    st[4 * n4 + 3] = st[4 * n4 + 3] * dec + xd * bv.w; y += st[4 * n4 + 3] * cv.w; }
                y += Dh * x;
                g2[row * 2048 + 1024 + h * 64 + lane] = (bf16)f2bf(y);
            }
        }
    }
}
__device__ __forceinline__ void ssd_norm_slow(const Args& a, int gw, int NGW, int lane) {
    bf16* g2 = (bf16*)(a.ws + WS_G2); const bf16* z = (const bf16*)(a.ws + WS_Z); const float* nw = a.in[I_SNW];
    for (int it = gw; it < T * NG; it += NGW) {
        const int row = it >> 1, g = it & 1, ch = 512 * g + 8 * lane;
        bf16* yp = g2 + (size_t)row * 2048 + 1024 + ch;
        const v4u yv = *(const v4u*)yp, zv = *(const v4u*)(z + (size_t)row * 1024 + ch);
        float gg[8]; const unsigned yw[4] = {yv.x, yv.y, yv.z, yv.w}, zw[4] = {zv.x, zv.y, zv.z, zv.w}; float ss = 0.f;
#pragma unroll
        for (int j = 0; j < 4; ++j) { gg[2 * j] = bflo(yw[j]) * silu_f(bflo(zw[j])); gg[2 * j + 1] = bfhi(yw[j]) * silu_f(bfhi(zw[j])); ss += gg[2 * j] * gg[2 * j] + gg[2 * j + 1] * gg[2 * j + 1]; }
        const float rinv = 1.0f / sqrtf(wave_sum(ss) * (1.f / 512.f) + EPS);
        v4u o; o.x = pk2(gg[0] * rinv * nw[ch], gg[1] * rinv * nw[ch + 1]); o.y = pk2(gg[2] * rinv * nw[ch + 2], gg[3] * rinv * nw[ch + 3]);
        o.z = pk2(gg[4] * rinv * nw[ch + 4], gg[5] * rinv * nw[ch + 5]); o.w = pk2(gg[6] * rinv * nw[ch + 6], gg[7] * rinv * nw[ch + 7]);
        *(v4u*)yp = o;
    }
}


constexpr int SS_ACUM = 0, SS_E2 = 4096, SS_EI = 8192, SS_R = 12288, SS_SSUM = 12416, SS_C = 16896, SS_CB = 51712, SS_X = 86528;
constexpr int SS_LD = 272, SS_XLD = 144;
static_assert(SS_X + 512 * SS_XLD <= LDS_BYTES - 64 && SS_C + 128 * SS_LD <= SS_CB && SS_CB + 128 * SS_LD <= SS_X, "SSD LDS map");
typedef float f32x4v __attribute__((ext_vector_type(4)));
__device__ __forceinline__ void unpack8(const v4u v, float* f);
__device__ __forceinline__ float wave_incl_scan(float v, int lane) {
#pragma unroll
    for (int o = 1; o < 64; o <<= 1) { const float t = bperm(v, lane >= o ? lane - o : lane); if (lane >= o) v += t; }
    return v;
}
template <int MODE>
__device__ __forceinline__ void ssd_tables(const Args& a, LAS unsigned char* lds, int b, int c, int g, int wave, int lane) {
    const float* dt = (const float*)(a.ws + WS_DT); const int h = 8 * g + wave; const float A = -expf(a.in[I_ALOG][h]);
    const size_t row0 = (size_t)b * SEQ + (size_t)c * CHK;
    const float d0 = dt[(row0 + 2 * lane) * 16 + h], d1 = dt[(row0 + 2 * lane + 1) * 16 + h];
    const float s1 = (d0 + d1) * A, incl = wave_incl_scan(s1, lane), ex = incl - s1;
    const float a0 = ex + d0 * A, a1 = incl, tot = bperm(incl, lane | 63);
    LAS float* acum = (LAS float*)(lds + SS_ACUM) + wave * 128; LAS float* e2 = (LAS float*)(lds + SS_E2) + wave * 128; LAS float* ei = (LAS float*)(lds + SS_EI) + wave * 128;
    acum[2 * lane] = a0; acum[2 * lane + 1] = a1;
    if (MODE == 0) { e2[2 * lane] = d0 * __expf(tot - a0); e2[2 * lane + 1] = d1 * __expf(tot - a1);
        if (lane == 0) ((float*)(a.ws + WS_CDEC))[((size_t)b * NCHK + c) * NH + h] = __expf(tot); }
    else {
        const float Rb = bperm(ex, lane & 48);
        e2[2 * lane] = d0 * __expf(fminf(Rb - a0, 80.f)); e2[2 * lane + 1] = d1 * __expf(fminf(Rb - a1, 80.f));
        ei[2 * lane] = __expf(a0); ei[2 * lane + 1] = __expf(a1);
        if ((lane & 15) == 0) ((LAS float*)(lds + SS_R))[wave * 4 + (lane >> 4)] = Rb; }
}
template <bool TRANS, bool SCALE>
__device__ __forceinline__ void conv_stage(const Args& a, LAS unsigned char* dst, int strideB, int b, int c, int col0, int nq, int t0, int ntb, const LAS float* scale, int wave) {
    const bf16* xbc = (const bf16*)(a.ws + WS_XBC); const float* cw = a.in[I_SCW]; const float* cb = a.in[I_SCB];
    const int tid_ = wave * 64 + lane_id_v();
    const int qd = tid_ % nq, ch = col0 + 4 * qd;
    const f32x4 w0 = *(const f32x4*)(cw + ch), w1 = *(const f32x4*)(cw + DXBC + ch), w2 = *(const f32x4*)(cw + 2 * DXBC + ch), w3 = *(const f32x4*)(cw + 3 * DXBC + ch), bs = *(const f32x4*)(cb + ch);
    for (int tb = tid_ / nq; tb < ntb; tb += NTHREADS / nq) {
        const int tl = t0 + 8 * tb, tab0 = c * CHK + tl;
        const bf16* src = xbc + ((size_t)b * SEQ + tab0) * DXBC + ch;
        v2u pin[11];
#pragma unroll
        for (int r = 0; r < 11; ++r) pin[r] = *(const v2u*)(src + (ptrdiff_t)((c > 0 || tl + r >= 3) ? r - 3 : 0) * DXBC);
        if (c == 0) {
#pragma unroll
            for (int r = 0; r < 3; ++r) if (tl + r < 3) pin[r] = (v2u){0u, 0u}; }
        if (TRANS) {
#pragma unroll
            for (int q = 0; q < 4; ++q) {
                float x[11];
#pragma unroll
                for (int r = 0; r < 11; ++r) { const unsigned wd = (q < 2) ? pin[r].x : pin[r].y; x[r] = (q & 1) ? bfhi(wd) : bflo(wd); }
                float o[8];
#pragma unroll
                for (int tt = 0; tt < 8; ++tt) { float v = bs[q] + w0[q] * x[tt] + w1[q] * x[tt + 1] + w2[q] * x[tt + 2] + w3[q] * x[tt + 3]; v = silu_fast(v); if (SCALE) v *= scale[((ch - col0) >> 6) * 128 + tl + tt]; o[tt] = v; }
                v4u w; w.x = pk2_hw(o[0], o[1]); w.y = pk2_hw(o[2], o[3]); w.z = pk2_hw(o[4], o[5]); w.w = pk2_hw(o[6], o[7]);
                *(LAS v4u*)(dst + (ch - col0 + q) * strideB + (tl - t0) * 2) = w; }
        } else {
#pragma unroll
            for (int tt = 0; tt < 8; ++tt) { float o[4];
#pragma unroll
                for (int q = 0; q < 4; ++q) { float xx[4];
#pragma unroll
                    for (int k = 0; k < 4; ++k) { const unsigned wd = (q < 2) ? pin[tt + k].x : pin[tt + k].y; xx[k] = (q & 1) ? bfhi(wd) : bflo(wd); }
                    o[q] = silu_fast(bs[q] + w0[q] * xx[0] + w1[q] * xx[1] + w2[q] * xx[2] + w3[q] * xx[3]); }
                v2u w; w.x = pk2_hw(o[0], o[1]); w.y = pk2_hw(o[2], o[3]); *(LAS v2u*)(dst + (tl - t0 + tt) * strideB + (ch - col0) * 2) = w; }
        }
    }
}
#define MFMA16(A_, B_, C_) __builtin_amdgcn_mfma_f32_16x16x32_bf16((A_), (B_), (C_), 0, 0, 0)
__device__ __forceinline__ void ssd_state_phase(const Args& a, LAS unsigned char* lds, int wg, int G, int wave) {
    bf16* S = (bf16*)((unsigned char*)a.out + DO_S);
    for (int u = wg; u < NBATCH * NCHK * NG; u += G) {
        const int g = u & 1, c = (u >> 1) & (NCHK - 1), b = u >> 7;
        const int lane = lane_id_v(); const int r = lane & 15, q = lane >> 4;
        __syncthreads();
        ssd_tables<0>(a, lds, b, c, g, wave, lane);
        conv_stage<true, false>(a, lds + SS_C, SS_LD, b, c, 1024 + 128 * g, 32, 0, 16, nullptr, wave);
        __syncthreads();
        f32x4 acc[8][4];
#pragma unroll
        for (int nt = 0; nt < 8; ++nt)
#pragma unroll
            for (int pt = 0; pt < 4; ++pt) acc[nt][pt] = (f32x4){0.f, 0.f, 0.f, 0.f};
        LAS unsigned char* BT = lds + SS_C; LAS unsigned char* XT = lds + SS_X;
        for (int jh = 0; jh < 2; ++jh) {
            if (jh) __syncthreads();
            conv_stage<true, true>(a, XT, SS_XLD, b, c, 512 * g, 128, 64 * jh, 8, (const LAS float*)(lds + SS_E2), wave);
            __syncthreads();
#pragma unroll
            for (int kk = 0; kk < 2; ++kk) { const int ks = 2 * jh + kk;
                bf16x8 xb[4];
#pragma unroll
                for (int pt = 0; pt < 4; ++pt) xb[pt] = *(const LAS bf16x8*)(XT + (64 * wave + 16 * pt + r) * SS_XLD + (32 * kk + 8 * q) * 2);
#pragma unroll
                for (int nt = 0; nt < 8; ++nt) { const bf16x8 bt = *(const LAS bf16x8*)(BT + (64 * (nt >> 2) + 16 * (r >> 2) + 4 * (nt & 3) + (r & 3)) * SS_LD + (32 * ks + 8 * q) * 2);
#pragma unroll
                    for (int pt = 0; pt < 4; ++pt) acc[nt][pt] = MFMA16(bt, xb[pt], acc[nt][pt]); }
            }
        }
        bf16* Sp = S + ((((size_t)b * NCHK + c) * NH + 8 * g + wave) * 64) * 128;
#pragma unroll
        for (int G4 = 0; G4 < 2; ++G4)
#pragma unroll
            for (int pt = 0; pt < 4; ++pt) { const f32x4 a0 = acc[4 * G4][pt], a1 = acc[4 * G4 + 1][pt], a2 = acc[4 * G4 + 2][pt], a3 = acc[4 * G4 + 3][pt];
                v4u o0, o1; o0.x = pk2(a0[0], a0[1]); o0.y = pk2(a0[2], a0[3]); o0.z = pk2(a1[0], a1[1]); o0.w = pk2(a1[2], a1[3]);
                o1.x = pk2(a2[0], a2[1]); o1.y = pk2(a2[2], a2[3]); o1.z = pk2(a3[0], a3[1]); o1.w = pk2(a3[2], a3[3]);
                bf16* dp = Sp + (16 * pt + r) * 128 + 64 * G4 + 16 * q; *(v4u*)dp = o0; *(v4u*)(dp + 8) = o1; }
    }
}
__device__ __forceinline__ void ssd_scan_phase(const Args& a, int wg, int G, int wave) {
    bf16* S = (bf16*)((unsigned char*)a.out + DO_S); const float* cdec = (const float*)(a.ws + WS_CDEC);
    for (int gid0 = wg * NTHREADS + wave * 64; gid0 < NBATCH * NH * 1024; gid0 += G * NTHREADS) {
        const int gid = gid0 + lane_id_v();
        const int bh = __builtin_amdgcn_readfirstlane(gid0 >> 10), e8 = gid & 1023, b = bh >> 4, h = bh & 15;
        float st[8];
#pragma unroll
        for (int j = 0; j < 8; ++j) st[j] = 0.f;
        bf16* Sp = S + ((size_t)b * NCHK * NH + h) * 8192 + 8 * e8; const float* dcp = cdec + (size_t)b * NCHK * NH + h;
        v4u sa[16], sb[16];
#define SCAN_LOAD(arr, c) _Pragma("unroll") for (int k_ = 0; k_ < 16; ++k_) arr[k_] = *(const v4u*)(Sp + (size_t)(16 * (c) + k_) * NH * 8192);
#define SCAN_COMP(arr, c) _Pragma("unroll") for (int k_ = 0; k_ < 16; ++k_) { const int ch = 16 * (c) + k_; const float dc = dcp[(size_t)ch * NH]; \
            v4u o; o.x = pk2(st[0], st[1]); o.y = pk2(st[2], st[3]); o.z = pk2(st[4], st[5]); o.w = pk2(st[6], st[7]); *(v4u*)(Sp + (size_t)ch * NH * 8192) = o; \
            float f[8]; unpack8(arr[k_], f); \
            _Pragma("unroll") for (int j = 0; j < 8; ++j) st[j] = st[j] * dc + f[j]; }
        static_assert(NCHK == 64, "scan unrolled for 64 chunks");
        SCAN_LOAD(sa, 0) SCAN_LOAD(sb, 1)
        SCAN_COMP(sa, 0) SCAN_LOAD(sa, 2)
        SCAN_COMP(sb, 1) SCAN_LOAD(sb, 3)
        SCAN_COMP(sa, 2) SCAN_COMP(sb, 3)
#undef SCAN_LOAD
#undef SCAN_COMP
    }
}
__device__ __forceinline__ void ssd_out_phase(const Args& a, LAS unsigned char* lds, int wg, int G, int wave) {
    const bf16* H = (const bf16*)((const unsigned char*)a.out + DO_S); const bf16* Z = (const bf16*)(a.ws + WS_Z); bf16* g2 = (bf16*)(a.ws + WS_G2);
    LAS unsigned char* Cl = lds + SS_C; LAS unsigned char* CBl = lds + SS_CB; LAS unsigned char* Bl = lds + SS_X; LAS unsigned char* XT = lds + SS_X;
    for (int u = wg; u < NBATCH * NCHK * NG; u += G) {
        const int g = u & 1, c = (u >> 1) & (NCHK - 1), b = u >> 7, h = 8 * g + wave;
        const int lane = lane_id_v(); const int r = lane & 15, q = lane >> 4;
        __syncthreads();
        ssd_tables<1>(a, lds, b, c, g, wave, lane);
        bf16x8 hf[4][4];
        { const bf16* Hp = H + ((((size_t)b * NCHK + c) * NH + h) * 64) * 128 + (16 * (r >> 2) + (r & 3)) * 128 + 8 * q;
#pragma unroll
          for (int ks = 0; ks < 4; ++ks)
#pragma unroll
              for (int pt = 0; pt < 4; ++pt) hf[ks][pt] = *(const bf16x8*)(Hp + 4 * pt * 128 + 32 * ks); }
        conv_stage<false, false>(a, Cl, SS_LD, b, c, 1280 + 128 * g, 32, 0, 16, nullptr, wave);
        conv_stage<false, false>(a, Bl, SS_LD, b, c, 1024 + 128 * g, 32, 0, 16, nullptr, wave);
        __syncthreads();
        { bf16x8 cf[4];
#pragma unroll
          for (int ks = 0; ks < 4; ++ks) cf[ks] = *(const LAS bf16x8*)(Cl + (16 * wave + r) * SS_LD + (32 * ks + 8 * q) * 2);
          for (int jt = 0; jt <= wave; ++jt) { f32x4 d = (f32x4){0.f, 0.f, 0.f, 0.f};
#pragma unroll
              for (int ks = 0; ks < 4; ++ks) { const bf16x8 bf = *(const LAS bf16x8*)(Bl + (16 * jt + r) * SS_LD + (32 * ks + 8 * q) * 2); d = MFMA16(bf, cf[ks], d); }
              v2u w; w.x = pk2(d[0], d[1]); w.y = pk2(d[2], d[3]); *(LAS v2u*)(CBl + (16 * wave + r) * SS_LD + (16 * jt + 4 * q) * 2) = w; } }
        f32x4 acc[8][4];
#pragma unroll
        for (int it = 0; it < 8; ++it)
#pragma unroll
            for (int pt = 0; pt < 4; ++pt) acc[it][pt] = (f32x4){0.f, 0.f, 0.f, 0.f};
#pragma unroll
        for (int ks = 0; ks < 4; ++ks) {
#pragma unroll
            for (int it = 0; it < 8; ++it) { const bf16x8 cf = *(const LAS bf16x8*)(Cl + (16 * it + r) * SS_LD + (32 * ks + 8 * q) * 2);
#pragma unroll
                for (int pt = 0; pt < 4; ++pt) acc[it][pt] = MFMA16(hf[ks][pt], cf, acc[it][pt]); __builtin_amdgcn_sched_barrier(0); } }
        const LAS float* acw = (const LAS float*)(lds + SS_ACUM) + wave * 128; const LAS float* e2w = (const LAS float*)(lds + SS_E2) + wave * 128; const LAS float* eiw = (const LAS float*)(lds + SS_EI) + wave * 128;
#pragma unroll
        for (int it = 0; it < 8; ++it) { const float e = eiw[16 * it + r];
#pragma unroll
            for (int pt = 0; pt < 4; ++pt) acc[it][pt] = acc[it][pt] * e; }
        const float Dh = a.in[I_DSKIP][h];
        for (int jh = 0; jh < 2; ++jh) {
            __syncthreads();
            conv_stage<true, false>(a, XT, SS_XLD, b, c, 512 * g, 128, 64 * jh, 8, nullptr, wave);
            __syncthreads();
#pragma unroll
            for (int kk = 0; kk < 2; ++kk) { const int ks = 2 * jh + kk; const int jb = 32 * ks + 8 * q;
                bf16x8 xf[4];
#pragma unroll
                for (int pt = 0; pt < 4; ++pt) xf[pt] = *(const LAS bf16x8*)(XT + (64 * wave + 16 * (r >> 2) + 4 * pt + (r & 3)) * SS_XLD + (32 * kk + 8 * q) * 2);
                const f32x4 ea = *(const LAS f32x4*)(e2w + jb), eb = *(const LAS f32x4*)(e2w + jb + 4); const float Rk = ((const LAS float*)(lds + SS_R))[wave * 4 + ks];
                const float e2v[8] = {ea[0], ea[1], ea[2], ea[3], eb[0], eb[1], eb[2], eb[3]};
#pragma unroll
                for (int it = 0; it < 8; ++it) { if (16 * it + 15 < 32 * ks) continue;
                    const int i = 16 * it + r; const v4u cbv = *(const LAS v4u*)(CBl + i * SS_LD + jb * 2);
                    float cbf[8]; unpack8(cbv, cbf); const float e1 = __expf(acw[i] - Rk); float mv[8];
                    if (16 * it >= 32 * ks + 32) {
#pragma unroll
                        for (int jj = 0; jj < 8; ++jj) mv[jj] = cbf[jj] * (e1 * e2v[jj]);
                    } else {
#pragma unroll
                        for (int jj = 0; jj < 8; ++jj) { float v = cbf[jj] * (e1 * e2v[jj]); const int j = jb + jj; v = (j <= i) ? v : 0.f; v = (j == i) ? v + Dh : v; mv[jj] = v; } }
                    v4u mw; mw.x = pk2_hw(mv[0], mv[1]); mw.y = pk2_hw(mv[2], mv[3]); mw.z = pk2_hw(mv[4], mv[5]); mw.w = pk2_hw(mv[6], mv[7]);
                    const bf16x8 mf = __builtin_bit_cast(bf16x8, mw);
#pragma unroll
                    for (int pt = 0; pt < 4; ++pt) acc[it][pt] = MFMA16(xf[pt], mf, acc[it][pt]); __builtin_amdgcn_sched_barrier(0); }
            }
        }
        const size_t row0 = (size_t)b * SEQ + (size_t)c * CHK; float ss[8];
        const bf16* zp0 = Z + (row0 + r) * 1024 + 512 * g + 64 * wave + 16 * q;
        v4u zA[4][2], zB[4][2];
#pragma unroll
        for (int it = 0; it < 4; ++it) { zA[it][0] = *(const v4u*)(zp0 + (size_t)(16 * it) * 1024); zA[it][1] = *(const v4u*)(zp0 + (size_t)(16 * it) * 1024 + 8); }
#pragma unroll
        for (int it = 0; it < 4; ++it) { zB[it][0] = *(const v4u*)(zp0 + (size_t)(16 * (it + 4)) * 1024); zB[it][1] = *(const v4u*)(zp0 + (size_t)(16 * (it + 4)) * 1024 + 8); }
#pragma unroll
        for (int it = 0; it < 8; ++it) { ss[it] = 0.f; float zf[16]; unpack8(it < 4 ? zA[it & 3][0] : zB[it & 3][0], zf); unpack8(it < 4 ? zA[it & 3][1] : zB[it & 3][1], zf + 8);
#pragma unroll
            for (int pt = 0; pt < 4; ++pt) { f32x4 v = acc[it][pt];
                v[0] *= zf[4 * pt]; v[1] *= zf[4 * pt + 1]; v[2] *= zf[4 * pt + 2]; v[3] *= zf[4 * pt + 3]; acc[it][pt] = v;     ss[it] += (v[0] * v[0] + v[1] * v[1]) + (v[2] * v[2] + v[3] * v[3]); }
            ss[it] += bperm(ss[it], lane ^ 16); ss[it] += bperm(ss[it], lane ^ 32); __builtin_amdgcn_sched_barrier(0); }
        LAS float* ssum = (LAS float*)(lds + SS_SSUM);
        if (q == 0) {
#pragma unroll
            for (int it = 0; it < 8; ++it) ssum[wave * 128 + 16 * it + r] = ss[it]; }
        __syncthreads();
        const float* nw = a.in[I_SNW] + 512 * g + 64 * wave + 16 * q;
        const f32x4 w0 = *(const f32x4*)nw, w1 = *(const f32x4*)(nw + 4), w2 = *(const f32x4*)(nw + 8), w3 = *(const f32x4*)(nw + 12);
#pragma unroll
        for (int it = 0; it < 8; ++it) { float t = 0.f;
#pragma unroll
            for (int w = 0; w < 8; ++w) t += ssum[w * 128 + 16 * it + r];
            const float rinv = 1.0f / sqrtf(t * (1.f / 512.f) + EPS); bf16* op = g2 + (row0 + 16 * it + r) * G2_LD + 1024 + 512 * g + 64 * wave + 16 * q;
            const f32x4 v0 = acc[it][0] * rinv * w0, v1 = acc[it][1] * rinv * w1, v2 = acc[it][2] * rinv * w2, v3 = acc[it][3] * rinv * w3;
            v4u o0, o1; o0.x = pk2(v0[0], v0[1]); o0.y = pk2(v0[2], v0[3]); o0.z = pk2(v1[0], v1[1]); o0.w = pk2(v1[2], v1[3]);
            o1.x = pk2(v2[0], v2[1]); o1.y = pk2(v2[2], v2[3]); o1.z = pk2(v3[0], v3[1]); o1.w = pk2(v3[2], v3[3]);
            *(v4u*)op = o0; *(v4u*)(op + 8) = o1; }
    }
}
__device__ __forceinline__ void unpack8(const v4u v, float* f) { f[0] = bflo(v.x); f[1] = bfhi(v.x); f[2] = bflo(v.y); f[3] = bfhi(v.y); f[4] = bflo(v.z); f[5] = bfhi(v.z); f[6] = bflo(v.w); f[7] = bfhi(v.w); }
constexpr int SCD = 4;
__device__ __forceinline__ void sc_phase(const Args& a, int gw, int NGW) {
    const int lane = lane_id();
    bf16* g2 = (bf16*)(a.ws + WS_G2); const bf16* pr = (const bf16*)(a.ws + WS_U);
    const int c0 = 16 * lane;
    float w0[16], w1[16], w2[16], nw[16];
#pragma unroll
    for (int j = 0; j < 16; ++j) { w0[j] = a.in[I_SCCW][c0 + j]; w1[j] = a.in[I_SCCW][1024 + c0 + j]; w2[j] = a.in[I_SCCW][2048 + c0 + j]; nw[j] = a.in[I_SCNW][c0 + j]; }
    for (int blk = gw; blk < T / 32; blk += NGW) {
        const int r0 = blk * 32; float p1[16], p2[16];
#pragma unroll
        for (int j = 0; j < 16; ++j) { p1[j] = 0.f; p2[j] = 0.f; }
        if ((r0 % SEQ) != 0) {
            unpack8(*(const v4u*)(pr + (size_t)(r0 - 1) * 1024 + c0), p1); unpack8(*(const v4u*)(pr + (size_t)(r0 - 1) * 1024 + c0 + 8), p1 + 8);
            unpack8(*(const v4u*)(pr + (size_t)(r0 - 2) * 1024 + c0), p2); unpack8(*(const v4u*)(pr + (size_t)(r0 - 2) * 1024 + c0 + 8), p2 + 8);
        }
        v4u nx[SCD][4];
#define SC_LOADROW(q, rowv) { const size_t rl_ = (size_t)(rowv); nx[q][0] = *(const v4u*)(pr + rl_ * 1024 + c0); nx[q][1] = *(const v4u*)(pr + rl_ * 1024 + c0 + 8); \
            nx[q][2] = *(const v4u*)(g2 + rl_ * G2_LD + c0); nx[q][3] = *(const v4u*)(g2 + rl_ * G2_LD + c0 + 8); }
#pragma unroll
        for (int q = 0; q < SCD; ++q) SC_LOADROW(q, r0 + q)
        for (int rr = 0; rr < 32; rr += SCD) {
#pragma unroll
            for (int q = 0; q < SCD; ++q) { const size_t row = (size_t)(r0 + rr + q);
                float pp[16], gb[16], val[16];
                unpack8(nx[q][0], pp); unpack8(nx[q][1], pp + 8); unpack8(nx[q][2], gb); unpack8(nx[q][3], gb + 8);
                { const int rn = r0 + rr + q + SCD; SC_LOADROW(q, rn < r0 + 32 ? rn : r0 + 31) }
                float ss = 0.f;
#pragma unroll
                for (int j = 0; j < 16; ++j) { const float p0 = pp[j]; const float v = w2[j] * p0 + w1[j] * p1[j] + w0[j] * p2[j]; p2[j] = p1[j]; p1[j] = p0; val[j] = gb[j] * v; ss += val[j] * val[j]; }
                const float rinv = 1.0f / sqrtf(wave_sum(ss) * (1.f / 1024.f) + EPS);
                v4u o0, o1;
                o0.x = pk2_hw(val[0] * rinv * nw[0], val[1] * rinv * nw[1]); o0.y = pk2_hw(val[2] * rinv * nw[2], val[3] * rinv * nw[3]); o0.z = pk2_hw(val[4] * rinv * nw[4], val[5] * rinv * nw[5]); o0.w = pk2_hw(val[6] * rinv * nw[6], val[7] * rinv * nw[7]);
                o1.x = pk2_hw(val[8] * rinv * nw[8], val[9] * rinv * nw[9]); o1.y = pk2_hw(val[10] * rinv * nw[10], val[11] * rinv * nw[11]); o1.z = pk2_hw(val[12] * rinv * nw[12], val[13] * rinv * nw[13]); o1.w = pk2_hw(val[14] * rinv * nw[14], val[15] * rinv * nw[15]);
                *(v4u*)(g2 + row * G2_LD + c0) = o0; *(v4u*)(g2 + row * G2_LD + c0 + 8) = o1;
            }
        }
#undef SC_LOADROW
    }
}

__device__ __forceinline__ void p5_slow(const Args& a, LAS unsigned char* lds, int wg, int G) {
    LAS float* As = (LAS float*)lds; LAS float* Bs = As + 32 * SG_LD;
    const bf16* g2 = (const bf16*)(a.ws + WS_G2); const bf16* wt = (const bf16*)(a.ws + WS_WOUT);
    const int t = threadIdx.x, tm = t >> 5, tn = t & 31;
    for (int it = wg; it < (T / 128) * 8; it += G) {
        const int mt = it >> 3, nt = it & 7;
        float acc[8][4];
        auto arow = [&](int r) { return g2 + (size_t)(mt * 128 + r) * 2048; };
        sg_tile(As, Bs, arow, wt + (size_t)nt * 128 * 2048, 2048, 2048, acc);
#pragma unroll
        for (int i = 0; i < 8; ++i) { const size_t off = (size_t)(mt * 128 + 8 * tm + i) * D + nt * 128 + 4 * tn;
            const f32x4 xv = *(const f32x4*)(a.in[I_X] + off);
            *(f32x4*)(a.out + off) = (f32x4){xv.x + acc[i][0], xv.y + acc[i][1], xv.z + acc[i][2], xv.w + acc[i][3]}; }
    }
}

__device__ __forceinline__ void p6_slow(const Args& a, LAS unsigned char* lds, int wg, int G) {
    const int tid = threadIdx.x, lane = tid & 63, wave = tid >> 6;
    LAS unsigned* lcnt = (LAS unsigned*)lds; LAS unsigned* lbase = lcnt + 32; LAS u64* pend = (LAS u64*)(lds + 256);
    const float* h = a.out; const float* nw = a.in[I_N2W]; const float* wr = a.in[I_WR]; const float* br = a.in[I_BR];
    bf16* xn2 = (bf16*)(a.ws + WS_XN2); unsigned* gcount = (unsigned*)(a.ws + WS_CTL) + CW_GCOUNT; u64* ent = (u64*)(a.ws + WS_ENT);
    for (int tb = wg; tb < T / 256; tb += G) {
        __syncthreads();
        if (tid < 32) lcnt[tid] = 0u;
        __syncthreads();
        const int tok0 = tb * 256;
        for (int r = wave; r < 256; r += NWAVES) rms_row_to_bf16(h + (size_t)(tok0 + r) * D, nw, xn2 + (size_t)(tok0 + r) * D, lane);
        const int rl = tid >> 5, e = tid & 31;
        for (int pass = 0; pass < 16; ++pass) {
            const int rloc = pass * 16 + rl, tok = tok0 + rloc; const float* hr = h + (size_t)tok * D;
            float s = 0.f, d = 0.f;
            for (int k = 0; k < D; ++k) { const float hv = hr[k]; s += hv * hv; d += hv * nw[k] * wr[k * NE + e]; }
            const float rinv = 1.0f / sqrtf(s * (1.f / D) + EPS);
            const float v = d * rinv + br[e];
            LAS float* lg = (LAS float*)(lds + 16384);
            __syncthreads();
            lg[rl * 32 + e] = v;
            __syncthreads();
            int rank = 0; float mx = -INFINITY;
#pragma unroll
            for (int e2 = 0; e2 < 32; ++e2) { const float o = lg[rl * 32 + e2]; rank += (o > v || (o == v && e2 < e)) ? 1 : 0; mx = fmaxf(mx, o); }
            const bool sel = rank < 4;
            const float ex = sel ? __expf(v - mx) : 0.f; float sum = ex;
#pragma unroll
            for (int o = 1; o < 32; o <<= 1) sum += __shfl_xor(sum, o);
            if (sel) { const unsigned r = __hip_atomic_fetch_add(&lcnt[e], 1u, __ATOMIC_RELAXED, __HIP_MEMORY_SCOPE_WORKGROUP);
                pend[rloc * 4 + rank] = ((u64)__builtin_bit_cast(unsigned, ex / sum) << 32) | (((unsigned)e << 20) | r); }
        }
        __syncthreads();
        if (tid < 32) lbase[tid] = atomicAdd(&gcount[64 * tid], lcnt[tid]);
        __syncthreads();
        for (int i = tid; i < 1024; i += NTHREADS) { const u64 p = pend[i]; const unsigned px = (unsigned)p, ee = px >> 20, rank = px & 0xfffffu;
            ent[(size_t)ee * ENT_CAP + lbase[ee] + rank] = (p & 0xffffffff00000000ull) | (u64)(unsigned)((tok0 + (i >> 2)) * 4 + (i & 3)); }
    }
}


constexpr int R16_LD = 1028;
template <int NE_>
__device__ __forceinline__ void rows16_stage_w(LAS float* WT, const float* W, int ldw, const float* nw, int wave) {
    for (int i0 = wave * 64 + lane_id(); i0 < 1024 * NE_; i0 += NTHREADS * 8) {
        float v[8];
#pragma unroll
        for (int u = 0; u < 8; ++u) { const int i = i0 + u * NTHREADS, k = i / NE_, e = i % NE_; v[u] = nw[k] * W[(size_t)k * ldw + e]; }
#pragma unroll
        for (int u = 0; u < 8; ++u) { const int i = i0 + u * NTHREADS, k = i / NE_, e = i % NE_; WT[e * R16_LD + k] = v[u]; } }
}
template <int NE_>
__device__ __forceinline__ void rows16_dots(const LAS float* WT, const float* src  , int lane, f32x4 (&acc)[NE_ / 16], float& ssq) {
    const int row = lane & 15, kq = lane >> 4;
    const f32x4* ap = (const f32x4*)(src + (size_t)row * D) + kq;
    const LAS f32x4* bp = (const LAS f32x4*)(WT + row * R16_LD) + kq;
#pragma unroll
    for (int t = 0; t < NE_ / 16; ++t) acc[t] = (f32x4){0.f, 0.f, 0.f, 0.f};
    float s = 0.f;
    f32x4 ca[16], cb[16];
#define R16_LOAD(arr, c) _Pragma("unroll") for (int i_ = 0; i_ < 16; ++i_) arr[i_] = ap[4 * (16 * (c) + i_)];
#define R16_COMP(arr, c) _Pragma("unroll") for (int i_ = 0; i_ < 16; ++i_) { const f32x4 av = arr[i_]; const int sidx = 16 * (c) + i_; \
        s += (av[0] * av[0] + av[1] * av[1]) + (av[2] * av[2] + av[3] * av[3]); \
        _Pragma("unroll") for (int t = 0; t < NE_ / 16; ++t) { const f32x4 bv = bp[(16 * t * R16_LD) / 4 + 4 * sidx]; \
            _Pragma("unroll") for (int j = 0; j < 4; ++j) acc[t] = __builtin_amdgcn_mfma_f32_16x16x4f32(av[j], bv[j], acc[t], 0, 0, 0); } }
    R16_LOAD(ca, 0) R16_LOAD(cb, 1)
    R16_COMP(ca, 0) R16_LOAD(ca, 2)
    R16_COMP(cb, 1) R16_LOAD(cb, 3)
    R16_COMP(ca, 2) R16_COMP(cb, 3)
#undef R16_LOAD
#undef R16_COMP
    s += bperm(s, lane ^ 16); s += bperm(s, lane ^ 32); ssq = s;
}
__device__ __forceinline__ void rows16_norm_store(const float* src, const float* w, bf16* dst, int dst_ld, float rinv_lane, int lane) {
    const f32x4* wr = (const f32x4*)w + lane;
#pragma unroll 4
    for (int i = 0; i < 16; ++i) { const float rinv = bperm(rinv_lane, (lane & 48) | i); const f32x4* xr = (const f32x4*)(src + (size_t)i * D) + lane; v2u* o8 = (v2u*)(dst + (size_t)i * dst_ld) + lane;
#pragma unroll
        for (int j = 0; j < 4; ++j) { const f32x4 v = xr[64 * j], ww = wr[64 * j]; v2u o; o.x = pk2_hw(v[0] * rinv * ww[0], v[1] * rinv * ww[1]); o.y = pk2_hw(v[2] * rinv * ww[2], v[3] * rinv * ww[3]); o8[64 * j] = o; } }
}

__device__ __forceinline__ void rows16_pass_router(const LAS float* WT, const LAS float* wl, const float* src, unsigned char* dst8, int lane, f32x4 (&acc)[2], float& ssq) {
    const int row = lane & 15, kq = lane >> 4;
    const f32x4* ap = (const f32x4*)(src + (size_t)row * D + 16 * kq);
    const LAS f32x4* bp = (const LAS f32x4*)(WT + row * R16_LD + 16 * kq); const LAS f32x4* wp = (const LAS f32x4*)(wl + 16 * kq);
    v4u* op = (v4u*)(dst8 + (size_t)row * D + 16 * kq);
    acc[0] = (f32x4){0.f, 0.f, 0.f, 0.f}; acc[1] = (f32x4){0.f, 0.f, 0.f, 0.f}; float s = 0.f;
    f32x4 ca[8], cb[8], cc[8];
#define RR_LOAD(arr, c) { _Pragma("unroll") for (int i_ = 0; i_ < 8; ++i_) arr[i_] = ap[16 * (2 * (c) + (i_ >> 2)) + (i_ & 3)]; __builtin_amdgcn_sched_barrier(0); }
#define RR_COMP(arr, c) _Pragma("unroll") for (int ss_ = 0; ss_ < 2; ++ss_) { const int S = 2 * (c) + ss_; v4u o_; \
        _Pragma("unroll") for (int jp = 0; jp < 4; ++jp) { const f32x4 x = arr[4 * ss_ + jp]; s += (x[0] * x[0] + x[1] * x[1]) + (x[2] * x[2] + x[3] * x[3]); \
            { const f32x4 bv0 = bp[16 * S + jp], bv1 = bp[(16 * R16_LD) / 4 + 16 * S + jp];     \
                _Pragma("unroll") for (int j = 0; j < 4; ++j) { acc[0] = __builtin_amdgcn_mfma_f32_16x16x4f32(x[j], bv0[j], acc[0], 0, 0, 0); acc[1] = __builtin_amdgcn_mfma_f32_16x16x4f32(x[j], bv1[j], acc[1], 0, 0, 0); } } \
            const f32x4 p = x * wp[16 * S + jp]; o_[jp] = pk4_fp8(p[0], p[1], p[2], p[3]); } \
        op[4 * S] = o_; }
    RR_LOAD(ca, 0) RR_LOAD(cb, 1) RR_LOAD(cc, 2)
    RR_COMP(ca, 0) RR_LOAD(ca, 3)
    RR_COMP(cb, 1) RR_LOAD(cb, 4)
    RR_COMP(cc, 2) RR_LOAD(cc, 5)
    RR_COMP(ca, 3) RR_LOAD(ca, 6)
    RR_COMP(cb, 4) RR_LOAD(cb, 7)
    RR_COMP(cc, 5) RR_COMP(ca, 6) RR_COMP(cb, 7)
#undef RR_LOAD
#undef RR_COMP
    s += bperm(s, lane ^ 16); s += bperm(s, lane ^ 32); ssq = s;
}
__device__ __forceinline__ void rows16_norm_store8(const float* src, const float* w, unsigned char* dst, float rinv_lane, int lane) {
    const f32x4* wr = (const f32x4*)w + lane;
#pragma unroll 4
    for (int i = 0; i < 16; ++i) { const float rinv = bperm(rinv_lane, (lane & 48) | i); const f32x4* xr = (const f32x4*)(src + (size_t)i * D) + lane; unsigned* o4 = (unsigned*)(dst + (size_t)i * D) + lane;
#pragma unroll
        for (int j = 0; j < 4; ++j) { const f32x4 v = xr[64 * j], ww = wr[64 * j]; o4[64 * j] = pk4_fp8(v[0] * rinv * ww[0], v[1] * rinv * ww[1], v[2] * rinv * ww[2], v[3] * rinv * ww[3]); } }
}
__device__ __forceinline__ void rows16_pass1(const LAS float* WT, const float* src, const LAS float* w, bf16* dst, int dst_ld, int lane, f32x4& acc, float& ssq) {
    const int row = lane & 15, kq = lane >> 4;
    const f32x4* ap = (const f32x4*)(src + (size_t)row * D + 16 * kq); const LAS f32x4* wp = (const LAS f32x4*)(w + 16 * kq);
    const LAS f32x4* bp = (const LAS f32x4*)(WT + row * R16_LD + 16 * kq);
    v4u* op = (v4u*)(dst + (size_t)row * dst_ld + 16 * kq);
    acc = (f32x4){0.f, 0.f, 0.f, 0.f}; float s = 0.f;
#pragma unroll 1
    for (int S2 = 0; S2 < 16; S2 += 2) {
        f32x4 av[2][4];
#pragma unroll
        for (int hs = 0; hs < 2; ++hs)
#pragma unroll
            for (int jp = 0; jp < 4; ++jp) av[hs][jp] = ap[16 * (S2 + hs) + jp];
        __builtin_amdgcn_sched_barrier(0);
#pragma unroll
        for (int hs = 0; hs < 2; ++hs) { const int S = S2 + hs; f32x4 pr[4];
#pragma unroll
            for (int jp = 0; jp < 4; ++jp) { const f32x4 x = av[hs][jp]; const f32x4 bv = bp[16 * S + jp]; s += (x[0] * x[0] + x[1] * x[1]) + (x[2] * x[2] + x[3] * x[3]);
#pragma unroll
                for (int j = 0; j < 4; ++j) acc = __builtin_amdgcn_mfma_f32_16x16x4f32(x[j], bv[j], acc, 0, 0, 0);
                pr[jp] = x * wp[16 * S + jp]; }
            v4u o0, o1;
            o0.x = pk2_hw(pr[0][0], pr[0][1]); o0.y = pk2_hw(pr[0][2], pr[0][3]); o0.z = pk2_hw(pr[1][0], pr[1][1]); o0.w = pk2_hw(pr[1][2], pr[1][3]);
            o1.x = pk2_hw(pr[2][0], pr[2][1]); o1.y = pk2_hw(pr[2][2], pr[2][3]); o1.z = pk2_hw(pr[3][0], pr[3][1]); o1.w = pk2_hw(pr[3][2], pr[3][3]);
            op[8 * S] = o0; op[8 * S + 1] = o1; }
    }
    s += bperm(s, lane ^ 16); s += bperm(s, lane ^ 32); ssq = s;
}
__device__ __forceinline__ void p0_rows_fast(const Args& a, LAS unsigned char* lds, int gw, int NGW, int wave) {
    LAS float* WT = (LAS float*)lds;
    __syncthreads();
    rows16_stage_w<16>(WT, a.in[I_WIN] + DT_COL0, PROJ_DIM, a.in[I_N1W], wave);
    LAS float* wl = (LAS float*)(lds + 66048);
    { const int tid = wave * 64 + lane_id(); wl[tid] = a.in[I_N1W][tid]; wl[tid + 512] = a.in[I_N1W][tid + 512]; }
    __syncthreads();
    float* dt = (float*)(a.ws + WS_DT); bf16* xn = (bf16*)((unsigned char*)a.out + DO_XN); float* rinvt = (float*)(a.ws + WS_RINV);
    for (int grp = gw; grp < T / 16; grp += NGW) {
        const int lane = lane_id_v();
        const float* src = a.in[I_X] + (size_t)grp * 16 * D;
        f32x4 acc; float ssq; rows16_pass1(WT, src, wl, xn + (size_t)grp * 16 * XN_LD, XN_LD, lane, acc, ssq);
        const float rinv = 1.0f / sqrtf(ssq * (1.f / D) + EPS);
        if (lane < 16) rinvt[(size_t)grp * 16 + lane] = rinv;
#pragma unroll
        for (int reg = 0; reg < 4; ++reg) { const int rr = 4 * (lane >> 4) + reg; const float ri = bperm(rinv, (lane & 48) | rr); dt[((size_t)grp * 16 + rr) * 16 + (lane & 15)] = softplus_f(acc[reg] * ri + a.in[I_DTB][lane & 15]); }
    }
}
__device__ __forceinline__ void p6_fast(const Args& a, LAS unsigned char* lds, int wg, int G, int wave) {
    LAS float* WT = (LAS float*)lds; LAS float* lg = (LAS float*)(lds + 131584) + wave * 512;
    LAS unsigned* lcnt = (LAS unsigned*)(lds + 147968); LAS unsigned* lbase = lcnt + 32; LAS u64* pend = (LAS u64*)(lds + 148224);
    LAS float* rinv_l = (LAS float*)(lds + 156416); LAS float* wl = (LAS float*)(lds + 157440);
    float* erinv = (float*)(a.ws + WS_ERINV);
    const float* h = a.out; bf16* xn2 = (bf16*)(a.ws + WS_XN2); unsigned* gcount = (unsigned*)(a.ws + WS_CTL) + CW_GCOUNT; u64* ent = (u64*)(a.ws + WS_ENT);
    __syncthreads();
    rows16_stage_w<32>(WT, a.in[I_WR], NE, a.in[I_N2W], wave);
    { const int tid = wave * 64 + lane_id(); wl[tid] = a.in[I_N2W][tid]; wl[tid + 512] = a.in[I_N2W][tid + 512]; }
    for (int tb = wg; tb < T / 256; tb += G) {
        __syncthreads();
        { const int tid = wave * 64 + lane_id(); if (tid < 32) lcnt[tid] = 0u; }
        __syncthreads();
        const int tok0 = tb * 256;
        for (int gi = 0; gi < 2; ++gi) {
            const int lane = lane_id_v();
            const int rbase = (wave * 2 + gi) * 16; const float* src = h + (size_t)(tok0 + rbase) * D;
            f32x4 acc[2]; float ssq; rows16_pass_router(WT, wl, src, (unsigned char*)xn2 + (size_t)(tok0 + rbase) * D, lane, acc, ssq);
            const float rinv = 1.0f / sqrtf(ssq * (1.f / D) + EPS);
            if (lane < 16) rinv_l[rbase + lane] = rinv;
            const int c = lane & 15, q = lane >> 4; const float b0 = a.in[I_BR][c], b1 = a.in[I_BR][16 + c];
#pragma unroll
            for (int reg = 0; reg < 4; ++reg) { const int rr = 4 * q + reg; const float ri = bperm(rinv, (lane & 48) | rr); lg[rr * 32 + c] = acc[0][reg] * ri + b0; lg[rr * 32 + 16 + c] = acc[1][reg] * ri + b1; }
            LDS_WAIT(); asm volatile("" ::: "memory");
            { const int tl = lane >> 2, part = lane & 3; float mine[8]; int rk[8];
              { const f32x4 m0 = *(const LAS f32x4*)(lg + tl * 32 + 8 * part), m1 = *(const LAS f32x4*)(lg + tl * 32 + 8 * part + 4);
                mine[0] = m0[0]; mine[1] = m0[1]; mine[2] = m0[2]; mine[3] = m0[3]; mine[4] = m1[0]; mine[5] = m1[1]; mine[6] = m1[2]; mine[7] = m1[3]; }
              unsigned km[8];
#pragma unroll
              for (int m = 0; m < 8; ++m) { rk[m] = 0; unsigned bb = __builtin_bit_cast(unsigned, mine[m]); bb ^= ((unsigned)((int)bb >> 31) | 0x80000000u); km[m] = (bb & ~31u) | (unsigned)(31 - (8 * part + m)); }
              float mx = -INFINITY;
#pragma unroll
              for (int j4 = 0; j4 < 8; ++j4) { const f32x4 v = *(const LAS f32x4*)(lg + tl * 32 + 4 * j4);
#pragma unroll
                  for (int jj = 0; jj < 4; ++jj) { const float o = v[jj]; mx = fmaxf(mx, o); unsigned bb = __builtin_bit_cast(unsigned, o); bb ^= ((unsigned)((int)bb >> 31) | 0x80000000u); const unsigned ko = (bb & ~31u) | (unsigned)(31 - (4 * j4 + jj));
#pragma unroll
                      for (int m = 0; m < 8; ++m) rk[m] += (ko > km[m]) ? 1 : 0; } }
              float exs = 0.f;
#pragma unroll
              for (int m = 0; m < 8; ++m) if (rk[m] < 4) exs += __expf(mine[m] - mx);
              exs += bperm(exs, lane ^ 1); exs += bperm(exs, lane ^ 2);
              const float inv = 1.0f / exs;
#pragma unroll
              for (int m = 0; m < 8; ++m) if (rk[m] < 4) { const int e = 8 * part + m; const unsigned rnk = __hip_atomic_fetch_add(&lcnt[e], 1u, __ATOMIC_RELAXED, __HIP_MEMORY_SCOPE_WORKGROUP);
                  pend[(rbase + tl) * 4 + rk[m]] = ((u64)__builtin_bit_cast(unsigned, __expf(mine[m] - mx) * inv) << 32) | (((unsigned)e << 20) | rnk); }
            }
            LDS_WAIT(); asm volatile("" ::: "memory");
        }
        __syncthreads();
        const int tid = wave * 64 + lane_id();
        if (tid < 32) lbase[tid] = atomicAdd(&gcount[64 * tid], lcnt[tid]);
        __syncthreads();
        for (int i = tid; i < 1024; i += NTHREADS) { const u64 p = pend[i]; const unsigned px = (unsigned)p, ee = px >> 20, rank = px & 0xfffffu;
            const size_t ei = (size_t)ee * ENT_CAP + lbase[ee] + rank;
            ent[ei] = (p & 0xffffffff00000000ull) | (u64)(unsigned)((tok0 + (i >> 2)) * 4 + (i & 3)); erinv[ei] = rinv_l[i >> 2]; }
    }
}
__device__ __forceinline__ void moe_tables(const Args& a, LAS unsigned* tab, int wave = -1) {
    const unsigned* gcount = (const unsigned*)(a.ws + WS_CTL) + CW_GCOUNT; const int tidx = wave < 0 ? (int)threadIdx.x : wave * 64 + lane_id();
    __syncthreads();
    if (tidx < 32) tab[tidx] = __hip_atomic_load(gcount + 64 * tidx, __ATOMIC_RELAXED, __HIP_MEMORY_SCOPE_AGENT);
    __syncthreads();
    if (tidx == 0) { unsigned p = 0; for (int e = 0; e < 32; ++e) { tab[32 + e] = p; p += (tab[e] + 255u) >> 8; } tab[64] = p; }
    __syncthreads();
}
__device__ __forceinline__ int moe_find_e(const LAS unsigned* tab, int gp) { int e = 0;
#pragma unroll
    for (int s = 16; s >= 1; s >>= 1) if (tab[32 + e + s] <= (unsigned)gp) e += s;
    return e; }
__device__ __forceinline__ float swiglu_f(float g, float u) { g = fminf(g, SWI_LIMIT); u = fminf(fmaxf(u, -SWI_LIMIT), SWI_LIMIT); return (u + 1.0f) * (g / (1.0f + __expf(-SWI_ALPHA * g))); }

__device__ __forceinline__ void p7_slow(const Args& a, LAS unsigned char* lds, int wg, int G) {
    LAS unsigned* tab = (LAS unsigned*)(lds + 40960); moe_tables(a, tab);
    LAS float* As = (LAS float*)lds; LAS float* Bs = As + 32 * SG_LD;
    const bf16* xn2 = (const bf16*)(a.ws + WS_XN2); const bf16* wgu = (const bf16*)(a.ws + WS_WGU); const u64* ent = (const u64*)(a.ws + WS_ENT);
    bf16* hid = (bf16*)(a.ws + WS_HID);
    const int t = threadIdx.x, tm = t >> 5, tn = t & 31, NP = (int)tab[64];
    for (int it = wg; it < NP * 16; it += G) {
        const int gp = it >> 4, half = (it >> 3) & 1, jt = it & 7, e = moe_find_e(tab, gp), pl = gp - (int)tab[32 + e], cnt = (int)tab[e];
        auto arow = [&](int r) { int pos = pl * 256 + half * 128 + r; pos = pos < cnt ? pos : cnt - 1; const unsigned tok = (unsigned)ent[(size_t)e * ENT_CAP + pos] >> 2; return xn2 + (size_t)tok * D; };
        float ag[8][4], au[8][4];
        const bf16* wb = wgu + (size_t)e * 2048 * D + (size_t)(256 * jt) * D;
        sg_tile(As, Bs, arow, wb, D, D, ag);
        sg_tile(As, Bs, arow, wb + (size_t)128 * D, D, D, au);
        const int j0 = 128 * jt + 4 * tn; const float* bg = a.in[I_BGU] + (size_t)e * 2048 + j0; const float* bu = bg + 1024;
#pragma unroll
        for (int i = 0; i < 8; ++i) { const size_t row = (size_t)gp * 256 + half * 128 + 8 * tm + i;
            v2u o; o.x = pk2(swiglu_f(ag[i][0] + bg[0], au[i][0] + bu[0]), swiglu_f(ag[i][1] + bg[1], au[i][1] + bu[1]));
            o.y = pk2(swiglu_f(ag[i][2] + bg[2], au[i][2] + bu[2]), swiglu_f(ag[i][3] + bg[3], au[i][3] + bu[3]));
            *(v2u*)(hid + row * FF + j0) = o; }
    }
}
__device__ __forceinline__ bf16* slot_ptr(unsigned char* ws, int k) { return (bf16*)(ws + (k == 0 ? WS_SLOT0 : (k == 1 ? WS_SLOT1 : (k == 2 ? WS_SLOT2 : WS_SLOT3)))); }
__device__ __forceinline__ void p8_slow(const Args& a, LAS unsigned char* lds, int wg, int G) {
    LAS unsigned* tab = (LAS unsigned*)(lds + 40960); moe_tables(a, tab);
    LAS float* As = (LAS float*)lds; LAS float* Bs = As + 32 * SG_LD;
    const bf16* hid = (const bf16*)(a.ws + WS_HID); const bf16* wd = (const bf16*)(a.ws + WS_WD); const u64* ent = (const u64*)(a.ws + WS_ENT);
    const int t = threadIdx.x, tm = t >> 5, tn = t & 31, NP = (int)tab[64];
    for (int it = wg; it < NP * 16; it += G) {
        const int gp = it >> 4, half = (it >> 3) & 1, nt = it & 7, e = moe_find_e(tab, gp), pl = gp - (int)tab[32 + e], cnt = (int)tab[e];
        auto arow = [&](int r) { return hid + ((size_t)gp * 256 + half * 128 + r) * FF; };
        float acc[8][4];
        sg_tile(As, Bs, arow, wd + (size_t)e * D * FF + (size_t)(128 * nt) * FF, FF, FF, acc);
        const int c0 = 128 * nt + 4 * tn; const float* bd = a.in[I_BD] + (size_t)e * D + c0;
#pragma unroll
        for (int i = 0; i < 8; ++i) { const int pos = pl * 256 + half * 128 + 8 * tm + i; if (pos >= cnt) continue;
            const u64 en = ent[(size_t)e * ENT_CAP + pos]; const unsigned enx = (unsigned)en; const float gt = __builtin_bit_cast(float, (unsigned)(en >> 32)); const int k = enx & 3; const size_t tok = enx >> 2;
            const float v0 = (acc[i][0] + bd[0]) * gt, v1 = (acc[i][1] + bd[1]) * gt, v2 = (acc[i][2] + bd[2]) * gt, v3 = (acc[i][3] + bd[3]) * gt;
            if (k == 0) { f32x4* p = (f32x4*)(a.out + tok * D + c0); const f32x4 o = *p; *p = (f32x4){o.x + v0, o.y + v1, o.z + v2, o.w + v3}; }
            else { v2u o; o.x = pk2(v0, v1); o.y = pk2(v2, v3); *(v2u*)(slot_ptr(a.ws, k) + tok * D + c0) = o; } }
    }
}

constexpr int EBUF_OFF = 131072 + 4096;
constexpr int TAB_OFF = 131072;
struct EpiProj {
    static constexpr bool PERM = true; static constexpr int NST = 8; unsigned char* ws;
    __device__ __forceinline__ void dma(const pg8::Unit& u, LAS unsigned char* eb, int wid, int lane) const {
        if (wid == 0) __builtin_amdgcn_global_load_lds((const unsigned*)((const float*)(ws + WS_RINV) + u.pm * 256 + 4 * lane), (LAS unsigned*)eb, 16, 0, 0);
    }
    __device__ __forceinline__ void operator()(const f32x4 (&acc)[2][2][4][2], const pg8::Unit& u, int wr, int wc, int fr, int fq, const LAS unsigned char* eb) const {
        const LAS float* rinvt = (const LAS float*)eb + wr * 64 + fr; float ri[2][4];
#pragma unroll
        for (int ai = 0; ai < 2; ++ai)
#pragma unroll
            for (int m = 0; m < 4; ++m) ri[ai][m] = rinvt[ai * 128 + m * 16];
        const int pn = u.pn; bf16* base; int ldc, colt;
        if (pn < 4) { base = (bf16*)(ws + WS_Z); ldc = 1024; colt = 256 * pn; } else if (pn < 10) { base = (bf16*)(ws + WS_XBC); ldc = DXBC; colt = 256 * (pn - 4); }
        else { base = (bf16*)(ws + WS_G2); ldc = G2_LD; colt = 256 * (pn - 10); }
        const int row0 = u.pm * 256 + wr * 64 + fr, col0 = colt + wc * 32 + 8 * fq;
        if (pn >= 14) {
            bf16* pb = (bf16*)(ws + WS_U) + (size_t)row0 * 1024 + 128 * (pn - 14) + wc * 32 + 8 * fq;
#pragma unroll
            for (int ai = 0; ai < 2; ++ai)
#pragma unroll
                for (int m = 0; m < 4; ++m) { const float r2 = ri[ai][m] * ri[ai][m];
                    const f32x4 v0 = acc[ai][0][m][0] * acc[ai][1][m][0] * r2, v1 = acc[ai][0][m][1] * acc[ai][1][m][1] * r2;
                    v4u w; w.x = pg8::cvt_pk_bf16(v0[0], v0[1]); w.y = pg8::cvt_pk_bf16(v0[2], v0[3]); w.z = pg8::cvt_pk_bf16(v1[0], v1[1]); w.w = pg8::cvt_pk_bf16(v1[2], v1[3]);
                    *(v4u*)(pb + (size_t)(ai * 128 + m * 16) * 1024) = w; }
            return; }
#pragma unroll
        for (int ai = 0; ai < 2; ++ai)
#pragma unroll
            for (int m = 0; m < 4; ++m) { bf16* rowp = base + (size_t)(row0 + ai * 128 + m * 16) * ldc + col0;
#pragma unroll
                for (int bj = 0; bj < 2; ++bj) { f32x4 v0 = acc[ai][bj][m][0] * ri[ai][m], v1 = acc[ai][bj][m][1] * ri[ai][m];
                    if (pn < 4) {
#pragma unroll
                        for (int j = 0; j < 4; ++j) { v0[j] = silu_fast(v0[j]); v1[j] = silu_fast(v1[j]); } }
                    v4u w; w.x = pg8::cvt_pk_bf16(v0[0], v0[1]); w.y = pg8::cvt_pk_bf16(v0[2], v0[3]); w.z = pg8::cvt_pk_bf16(v1[0], v1[1]); w.w = pg8::cvt_pk_bf16(v1[2], v1[3]);
                    *(v4u*)(rowp + bj * 128) = w; } }
    }
};
struct EpiResid {
    static constexpr bool PERM = false; static constexpr int NST = 32; const float* x; float* out;
    __device__ __forceinline__ void dma(const pg8::Unit&, LAS unsigned char*, int, int) const {}
    __device__ __forceinline__ void operator()(const f32x4 (&acc)[2][2][4][2], const pg8::Unit& u, int wr, int wc, int fr, int fq, const LAS unsigned char*) const {
        const int row0 = u.pm * 256 + wr * 64 + fr, col0 = u.pn * 256 + wc * 32 + 4 * fq;
#pragma unroll
        for (int ai = 0; ai < 2; ++ai)
#pragma unroll
            for (int m = 0; m < 4; ++m) { const size_t off = (size_t)(row0 + ai * 128 + m * 16) * D + col0;
#pragma unroll
                for (int bj = 0; bj < 2; ++bj)
#pragma unroll
                    for (int n = 0; n < 2; ++n) { const f32x4 xv = *(const f32x4*)(x + off + bj * 128 + n * 16); *(f32x4*)(out + off + bj * 128 + n * 16) = xv + acc[ai][bj][m][n]; } }
    }
};

constexpr float W8_SCALE = 32.0f, W8_INV = 1.0f / 32.0f;
__device__ __forceinline__ float clamp448(float v) { return __builtin_amdgcn_fmed3f(v, -448.f, 448.f); }
__device__ __forceinline__ unsigned pk4_fp8(float a, float b, float c, float d) { unsigned w = 0; w = __builtin_amdgcn_cvt_pk_fp8_f32(clamp448(a), clamp448(b), w, false); w = __builtin_amdgcn_cvt_pk_fp8_f32(clamp448(c), clamp448(d), w, true); return w; }
__device__ __forceinline__ unsigned pk4_fp8_nc(float a, float b, float c, float d) { unsigned w = 0; w = __builtin_amdgcn_cvt_pk_fp8_f32(a, b, w, false); w = __builtin_amdgcn_cvt_pk_fp8_f32(c, d, w, true); return w; }
__device__ __forceinline__ float swiglu_fast(float g, float u1) { g = fminf(g, SWI_LIMIT); u1 = __builtin_amdgcn_fmed3f(u1, 1.0f - SWI_LIMIT, 1.0f + SWI_LIMIT);
    return u1 * g * __builtin_amdgcn_rcpf(1.0f + __builtin_amdgcn_exp2f(g * (-SWI_ALPHA * 1.44269504f))); }
struct EpiSwiglu {
    static constexpr bool PERM = true; static constexpr int NST = 8; const float* bgu; unsigned char* hid; const float* erinv; const LAS unsigned* tab;
    __device__ __forceinline__ void dma(const pg8::Unit& u, LAS unsigned char* eb, int wid, int lane) const {
        const int e = u.aux;
        if (wid == 0) __builtin_amdgcn_global_load_lds((const unsigned*)(bgu + (size_t)e * 2048 + (lane >> 5) * 1024 + 128 * u.pn + 4 * (lane & 31)), (LAS unsigned*)eb, 16, 0, 0);
        if (wid == 1) { const int pl = u.pm - (int)tab[32 + e]; __builtin_amdgcn_global_load_lds((const unsigned*)(erinv + (size_t)e * ENT_CAP + pl * 256 + 4 * lane), (LAS unsigned*)(eb + 1024), 16, 0, 0); }
    }
    __device__ __forceinline__ void operator()(const f32x4 (&acc)[2][2][4][2], const pg8::Unit& u, int wr, int wc, int fr, int fq, const LAS unsigned char* eb) const {
        const int j0 = 128 * u.pn + wc * 32 + 8 * fq; const LAS float* bg = (const LAS float*)eb + wc * 32 + 8 * fq;
        const f32x4 g0 = *(const LAS f32x4*)bg, g1 = *(const LAS f32x4*)(bg + 4), u0 = *(const LAS f32x4*)(bg + 128) + 1.0f, u1 = *(const LAS f32x4*)(bg + 132) + 1.0f;
        const LAS float* erp = (const LAS float*)(eb + 1024) + wr * 64 + fr; float rs[2][4];
#pragma unroll
        for (int ai = 0; ai < 2; ++ai)
#pragma unroll
            for (int m = 0; m < 4; ++m) rs[ai][m] = erp[ai * 128 + m * 16];
#pragma unroll
        for (int ai = 0; ai < 2; ++ai) {
#pragma unroll
            for (int m = 0; m < 4; ++m) { const size_t row = (size_t)u.pm * 256 + ai * 128 + wr * 64 + m * 16 + fr;
                const float rsc = rs[ai][m] * W8_INV; const f32x4 a0 = acc[ai][0][m][0] * rsc + g0, a1 = acc[ai][0][m][1] * rsc + g1, b0 = acc[ai][1][m][0] * rsc + u0, b1 = acc[ai][1][m][1] * rsc + u1;
                v2u w; w.x = pk4_fp8_nc(swiglu_fast(a0[0], b0[0]), swiglu_fast(a0[1], b0[1]), swiglu_fast(a0[2], b0[2]), swiglu_fast(a0[3], b0[3]));
                w.y = pk4_fp8_nc(swiglu_fast(a1[0], b1[0]), swiglu_fast(a1[1], b1[1]), swiglu_fast(a1[2], b1[2]), swiglu_fast(a1[3], b1[3]));
                *(v2u*)(hid + row * FF + j0) = w; } }
    }
};
struct EpiDown {
    static constexpr bool PERM = true; static constexpr int NST = 0; const float* bd; const u64* ent; const LAS unsigned* tab; float* out; unsigned char* ws;
    __device__ __forceinline__ void dma(const pg8::Unit& u, LAS unsigned char* eb, int wid, int lane) const {
        const int e = u.aux;
        if (wid == 0) __builtin_amdgcn_global_load_lds((const unsigned*)(bd + (size_t)e * D + 256 * u.pn + 4 * lane), (LAS unsigned*)eb, 16, 0, 0);
        if (wid == 1 || wid == 2) { const int pl = u.pm - (int)tab[32 + e];
            __builtin_amdgcn_global_load_lds((const unsigned*)(ent + (size_t)e * ENT_CAP + pl * 256 + 128 * (wid - 1) + 2 * lane), (LAS unsigned*)(eb + 1024 + 1024 * (wid - 1)), 16, 0, 0); }
    }
    __device__ __forceinline__ void operator()(const f32x4 (&acc)[2][2][4][2], const pg8::Unit& u, int wr, int wc, int fr, int fq, const LAS unsigned char* eb) const {
        const int e = u.aux, pl = u.pm - (int)tab[32 + e], cnt = (int)tab[e], c0 = 256 * u.pn + wc * 32 + 8 * fq; const LAS float* bp = (const LAS float*)eb + wc * 32 + 8 * fq;
        f32x4 bv[2][2];
#pragma unroll
        for (int bj = 0; bj < 2; ++bj) { bv[bj][0] = *(const LAS f32x4*)(bp + bj * 128); bv[bj][1] = *(const LAS f32x4*)(bp + bj * 128 + 4); }
        const LAS u64* enp = (const LAS u64*)(eb + 1024) + wr * 64 + fr; u64 en8[2][4];
#pragma unroll
        for (int ai = 0; ai < 2; ++ai)
#pragma unroll
            for (int m = 0; m < 4; ++m) en8[ai][m] = enp[ai * 128 + m * 16];
#pragma unroll
        for (int ai = 0; ai < 2; ++ai)
#pragma unroll
            for (int m = 0; m < 4; ++m) { const int pos = pl * 256 + ai * 128 + wr * 64 + m * 16 + fr; if (pos >= cnt) continue;
                const u64 en = en8[ai][m]; const unsigned enx = (unsigned)en; const float gt = __builtin_bit_cast(float, (unsigned)(en >> 32)); const int k = enx & 3; const size_t tok = enx >> 2;
                bf16* dst = slot_ptr(ws, k) + tok * D + c0;
#pragma unroll
                for (int bj = 0; bj < 2; ++bj) { const f32x4 v0 = (acc[ai][bj][m][0] * W8_INV + bv[bj][0]) * gt, v1 = (acc[ai][bj][m][1] * W8_INV + bv[bj][1]) * gt;
                    v4u w; w.x = pg8::cvt_pk_bf16(v0[0], v0[1]); w.y = pg8::cvt_pk_bf16(v0[2], v0[3]); w.z = pg8::cvt_pk_bf16(v1[0], v1[1]); w.w = pg8::cvt_pk_bf16(v1[2], v1[3]);
                    *(v4u*)(dst + bj * 128) = w; } }
    }
};
struct MoeSched {
    const LAS unsigned* tab; int NP, npn, G, vc; const u64* ent; const char* Bt; size_t estepB, tstepB; bool gather; unsigned rowB, ldbB;
    __device__ __forceinline__ void init(const LAS unsigned* tab_, int npn_, int G_, int c, const u64* ent_, const void* Bt_, size_t estepB_, size_t tstepB_, bool gather_, unsigned rowB_) { rowB = rowB_; ldbB = rowB_;
        tab = tab_; NP = (int)tab_[64]; npn = npn_; G = G_; vc = (G_ % 8 == 0) ? (c & 7) * (G_ / 8) + (c >> 3) : c; ent = ent_; Bt = (const char*)Bt_; estepB = estepB_; tstepB = tstepB_; gather = gather_; }
    bool rev = false;
    __device__ __forceinline__ bool next(int i, pg8::Unit& u) const { int ug = i * G + vc; if (ug >= NP * npn) return false; if (rev) ug = NP * npn - 1 - ug; u.pm = ug / npn; u.pn = ug % npn; u.aux = moe_find_e(tab, u.pm); return true; }
    __device__ __forceinline__ void a_offs(const pg8::Unit& u, int tid, unsigned (&o0)[2], unsigned (&o1)[2]) const {
        int R[2], C[2]; pg8::stage_rc(tid * 16, R[0], C[0]); pg8::stage_rc(tid * 16 + 8192, R[1], C[1]);
        if (gather) { const int e = u.aux, pl = u.pm - (int)tab[32 + e], cnt = (int)tab[e];
#pragma unroll
            for (int i = 0; i < 2; ++i) { int p0 = pl * 256 + R[i], p1 = p0 + 128; p0 = p0 < cnt ? p0 : cnt - 1; p1 = p1 < cnt ? p1 : cnt - 1;
                const unsigned t0 = (unsigned)ent[(size_t)e * ENT_CAP + p0] >> 2, t1 = (unsigned)ent[(size_t)e * ENT_CAP + p1] >> 2;
                o0[i] = t0 * rowB + (unsigned)C[i] * 2u; o1[i] = t1 * rowB + (unsigned)C[i] * 2u; } }
        else {
#pragma unroll
            for (int i = 0; i < 2; ++i) { o0[i] = (unsigned)(u.pm * 256 + R[i]) * rowB + (unsigned)C[i] * 2u; o1[i] = o0[i] + 128u * rowB; } }
    }
    __device__ __forceinline__ const char* b_base(const pg8::Unit& u) const { return Bt + (size_t)u.aux * estepB + (size_t)u.pn * tstepB; }
};
__device__ __forceinline__ void p1_fast(const Args& a, LAS unsigned char* lds, int wg, int G, int wave) {
    pg8::DenseSched S; S.init(T, NPROJ, G, wg, XN_LD); S.GS = 4; S.Bt = (const char*)(a.ws + WS_WIN); S.tstepB = (size_t)256 * WIN_LD * 2; S.ldbB = WIN_LD * 2;
    EpiProj E{a.ws};
    pg8::gemm_phase<EpiProj, pg8::DenseSched, true>(lds, (const char*)a.out + DO_XN, D, S, E, wave);
}
__device__ __forceinline__ void p5_fast(const Args& a, LAS unsigned char* lds, int wg, int G, int wave) {
    pg8::DenseSched S; S.init(T, D, G, wg, G2_LD); S.rev = true; S.Bt = (const char*)(a.ws + WS_WOUT); S.tstepB = (size_t)256 * WOUT_LD * 2; S.ldbB = WOUT_LD * 2;
    EpiResid E{a.in[I_X], a.out};
    pg8::gemm_phase<EpiResid, pg8::DenseSched, true>(lds, (const char*)(a.ws + WS_G2), 2048, S, E, wave);
}
__device__ __forceinline__ void p7_fast(const Args& a, LAS unsigned char* lds, int wg, int G, int wave) {
    LAS unsigned* tab = (LAS unsigned*)(lds + TAB_OFF); moe_tables(a, tab, wave);
    MoeSched S; S.init(tab, 8, G, wg, (const u64*)(a.ws + WS_ENT), a.ws + WS_WGU, (size_t)2048 * D, (size_t)256 * D, true, (unsigned)D);
    EpiSwiglu E{a.in[I_BGU], a.ws + WS_HID, (const float*)(a.ws + WS_ERINV), tab};
    pg8::gemm_phase<EpiSwiglu, MoeSched, true, true>(lds, (const char*)(a.ws + WS_XN2), D / 2, S, E, wave);
}
__device__ __forceinline__ void p8_fast(const Args& a, LAS unsigned char* lds, int wg, int G, int wave) {
    LAS unsigned* tab = (LAS unsigned*)(lds + TAB_OFF); moe_tables(a, tab, wave);
    MoeSched S; S.init(tab, 4, G, wg, (const u64*)(a.ws + WS_ENT), a.ws + WS_WD, (size_t)D * FF, (size_t)256 * FF, false, (unsigned)FF); S.rev = true;
    EpiDown E{a.in[I_BD], (const u64*)(a.ws + WS_ENT), tab, a.out, a.ws};
    pg8::gemm_phase<EpiDown, MoeSched, true, true>(lds, (const char*)(a.ws + WS_HID), FF / 2, S, E, wave);
}
__device__ __forceinline__ void p9_final(const Args& a, int gw, int NGW) {
    const int lane = lane_id();
    const bf16* s0 = (const bf16*)(a.ws + WS_SLOT0); const bf16* s1 = (const bf16*)(a.ws + WS_SLOT1); const bf16* s2 = (const bf16*)(a.ws + WS_SLOT2); const bf16* s3 = (const bf16*)(a.ws + WS_SLOT3);
    const f32x4* wr = (const f32x4*)a.in[I_FNW] + lane;
    constexpr int RF = 4;
    for (int row0 = gw; row0 < T; row0 += RF * NGW) {
        f32x4 v[RF][4]; v2u sa[RF][4][4];
#pragma unroll
        for (int rr = 0; rr < RF; ++rr) { int row = row0 + rr * NGW; row = row < T ? row : T - 1; const f32x4* xr = (const f32x4*)(a.out + (size_t)row * D) + lane;
#pragma unroll
            for (int j = 0; j < 4; ++j) { v[rr][j] = xr[64 * j]; const size_t o = (size_t)row * D + 4 * lane + 256 * j; sa[rr][j][0] = *(const v2u*)(s1 + o); sa[rr][j][1] = *(const v2u*)(s2 + o); sa[rr][j][2] = *(const v2u*)(s3 + o); sa[rr][j][3] = *(const v2u*)(s0 + o); } }
#pragma unroll
        for (int rr = 0; rr < RF; ++rr) { int row = row0 + rr * NGW; row = row < T ? row : T - 1; f32x4* xr = (f32x4*)(a.out + (size_t)row * D) + lane; float s = 0.f;
#pragma unroll
            for (int j = 0; j < 4; ++j) { const v2u a1 = sa[rr][j][0], a2 = sa[rr][j][1], a3 = sa[rr][j][2], a0 = sa[rr][j][3]; f32x4 t = v[rr][j];
                t[0] += (bflo(a0.x) + bflo(a1.x)) + (bflo(a2.x) + bflo(a3.x)); t[1] += (bfhi(a0.x) + bfhi(a1.x)) + (bfhi(a2.x) + bfhi(a3.x)); t[2] += (bflo(a0.y) + bflo(a1.y)) + (bflo(a2.y) + bflo(a3.y)); t[3] += (bfhi(a0.y) + bfhi(a1.y)) + (bfhi(a2.y) + bfhi(a3.y));
                v[rr][j] = t; s += (t[0] * t[0] + t[1] * t[1]) + (t[2] * t[2] + t[3] * t[3]); }
            const float rinv = 1.0f / sqrtf(wave_sum(s) * (1.f / D) + EPS);
            if (row0 + rr * NGW < T) {
#pragma unroll
                for (int j = 0; j < 4; ++j) { const f32x4 ww = wr[64 * j]; xr[64 * j] = v[rr][j] * rinv * ww; } } }
    }
}

constexpr int NPHASES = 12;
__global__ void __launch_bounds__(NTHREADS, 2) fwd(Args a) {
    extern __shared__ __attribute__((aligned(16))) unsigned char lds_raw[];
    LAS unsigned char* lds = (LAS unsigned char*)lds_raw;
    const int wave = __builtin_amdgcn_readfirstlane((int)threadIdx.x >> 6);
    const int G = gridDim.x, wg = blockIdx.x, gw = wg * NWAVES + wave, NGW = G * NWAVES;
    volatile LAS unsigned* misc = (volatile LAS unsigned*)(lds + LDS_BYTES - 64);
    if (wave == 0 && lane_id() < 16) misc[lane_id()] = 0u;
    __syncthreads();
    XcdBarrier bar; bar.bar = (unsigned*)(a.ws + WS_CTL) + CW_BAR; bar.x = 0; bar.st = nullptr; bar.wave = wave;
    if (N_LAUNCHES == 1) bar = xcd_barrier_post((unsigned*)(a.ws + WS_CTL) + CW_BAR, misc, wave);
    const int lo = a.ph_lo, hi = a.ph_hi;
#define IN(k) (lo <= (k) && (k) < hi)
#define SEAM(k) do { if (IN(k) && IN((k) + 1)) { if (N_LAUNCHES == 1) xcd_barrier(bar); } } while (0)
    if (IN(0)) { p0_weights<false>(a, lds, gw, NGW, wave); p0_rows_fast(a, lds, gw, NGW, wave); }
    SEAM(0);
    if (IN(1)) {
        if ((wg >> 3) & 1) { p1_fast(a, lds, wg, G, wave); p0_weights<true>(a, lds, gw, NGW, wave); } else { p0_weights<true>(a, lds, gw, NGW, wave); __syncthreads(); p1_fast(a, lds, wg, G, wave); } }
    SEAM(1);
    if (IN(2)) {
        if ((wg >> 3) & 1) { sc_phase(a, gw, NGW); ssd_state_phase(a, lds, wg, G, wave); } else { ssd_state_phase(a, lds, wg, G, wave); sc_phase(a, gw, NGW); } }
    SEAM(2);
    if (IN(3)) ssd_scan_phase(a, wg, G, wave);
    SEAM(3);
    if (IN(4)) ssd_out_phase(a, lds, wg, G, wave);
    SEAM(4);
    if (IN(5)) p5_fast(a, lds, wg, G, wave);
    SEAM(5);
    if (IN(6)) p6_fast(a, lds, wg, G, wave);
    SEAM(6);
    if (IN(7)) p7_fast(a, lds, wg, G, wave);
    SEAM(7);
    if (IN(8)) p8_fast(a, lds, wg, G, wave);
    SEAM(8);
    if (IN(9)) p9_final(a, gw, NGW);
#undef IN
#undef SEAM
}

extern "C" void kernel_launch(void* const* d_in, const int* in_sizes, int n_in, void* d_out, int out_size, void* d_ws, size_t ws_size, hipStream_t stream) {
    static int grid = 0;
    if (grid == 0) {
        if (n_in != 20 || in_sizes[0] != T * D || out_size != T * D || ws_size < WS_END) { fprintf(stderr, "kernel_launch: unexpected shapes (n_in %d, in0 %d, out %d, ws %zu)\n", n_in, n_in > 0 ? in_sizes[0] : -1, out_size, ws_size); grid = -1; return; }
        int dev = 0, cus = 0, per_cu = 0;
        if (hipGetDevice(&dev) != hipSuccess || hipDeviceGetAttribute(&cus, hipDeviceAttributeMultiprocessorCount, dev) != hipSuccess) { grid = -1; return; }
        if (hipFuncSetAttribute((const void*)fwd, hipFuncAttributeMaxDynamicSharedMemorySize, LDS_BYTES) != hipSuccess) { fprintf(stderr, "kernel_launch: hipFuncSetAttribute failed\n"); grid = -1; return; }
        if (hipOccupancyMaxActiveBlocksPerMultiprocessor(&per_cu, (const void*)fwd, NTHREADS, LDS_BYTES) != hipSuccess || per_cu < 1) fprintf(stderr, "kernel_launch: occupancy query reports %d\n", per_cu);
        (void)hipGetLastError();
        grid = cus;
    }
    if (grid < 0) return;
    (void)hipMemsetAsync((char*)d_ws + WS_CTL, 0, CTL_ZERO_BYTES, stream);
    Args a{};
    for (int i = 0; i < 20; ++i) a.in[i] = (const float*)d_in[i];
    a.out = (float*)d_out; a.ws = (unsigned char*)d_ws;
    if (N_LAUNCHES == 1) { a.ph_lo = 0; a.ph_hi = NPHASES; hipLaunchKernelGGL(fwd, dim3(grid), dim3(NTHREADS), LDS_BYTES, stream, a); }
    else for (int p = 0; p < 10; ++p) { a.ph_lo = p; a.ph_hi = p + 1; hipLaunchKernelGGL(fwd, dim3(grid), dim3(NTHREADS), LDS_BYTES, stream, a); }
}
```

```cpp
#include <hip/hip_runtime.h>
#include <cstdio>
#include <cstdint>

#ifndef FAST
#define FAST 0x1FF
#endif
#ifndef N_LAUNCHES
#define N_LAUNCHES 1
#endif

#define GAS __attribute__((address_space(1)))
#define LAS __attribute__((address_space(3)))
typedef unsigned short bf16;
typedef unsigned v4u __attribute__((ext_vector_type(4)));
typedef unsigned v2u __attribute__((ext_vector_type(2)));
typedef unsigned long long u64;
typedef float f32x4 __attribute__((ext_vector_type(4)));
typedef float f32x2 __attribute__((ext_vector_type(2)));
typedef short bf16x8 __attribute__((ext_vector_type(8)));

constexpr int D = 1024, NBATCH = 8, SEQ = 8192, T = NBATCH * SEQ;
constexpr int NH = 16, HD = 64, NG = 2, HPG = 8, DST = 128, CHK = 128, NCHK = SEQ / CHK;
constexpr int DXBC = 1536, NPROJ = 5632, PROJ_DIM = 5648, DT_COL0 = 2560;
constexpr int NE = 32, FF = 1024;
constexpr float EPS = 1e-5f, SWI_LIMIT = 7.0f, SWI_ALPHA = 1.702f;
constexpr int XN_LD = 1088, WIN_LD = 1088, G2_LD = 2112, WOUT_LD = 2112;
constexpr int ENT_CAP = 65536;
constexpr int HID_ROWS = 270336;
enum { I_X = 0, I_N1W, I_WIN, I_SCW, I_SCB, I_DTB, I_ALOG, I_DSKIP, I_SNW, I_SCCW, I_SCNW, I_WOUT, I_N2W, I_WR, I_BR, I_WGU, I_BGU, I_WD, I_BD, I_FNW };

constexpr size_t MiB = 1u << 20;
constexpr size_t WS_CTL = 0, CTL_ZERO_BYTES = 1 * MiB;
constexpr size_t WS_DT = 1 * MiB;
constexpr size_t WS_CDEC = 5 * MiB;
constexpr size_t WS_RINV = 5 * MiB + 512 * 1024;
constexpr size_t WS_WIN = 6 * MiB;
constexpr size_t WS_WOUT = 18 * MiB;
constexpr size_t WS_ENT = 23 * MiB;
constexpr size_t WS_WD = 40 * MiB;
constexpr size_t WS_WGU = 104 * MiB;
constexpr size_t WS_Z = 232 * MiB;
constexpr size_t WS_XBC = 360 * MiB;
constexpr size_t WS_G2 = 552 * MiB;
constexpr size_t WS_U = 816 * MiB;
constexpr size_t WS_XN2 = 232 * MiB;
constexpr size_t WS_HID = 360 * MiB;
constexpr size_t SLOT_SKEW = 1 * MiB + 68 * 1024 + 256;
constexpr size_t WS_SLOT0 = 624 * MiB, WS_SLOT1 = 72 * MiB + SLOT_SKEW, WS_SLOT2 = 200 * MiB + 2 * SLOT_SKEW, WS_SLOT3 = 752 * MiB + 3 * SLOT_SKEW;
constexpr size_t WS_END = 1016 * MiB;
constexpr size_t WS_ERINV = WS_WIN;
static_assert((size_t)NE * ENT_CAP * 4 <= (size_t)NPROJ * WIN_LD * 2, "erinv fits in the dead in-projection weights");
static_assert(WS_WIN + (size_t)NPROJ * WIN_LD * 2 <= WS_WOUT && WS_WOUT + (size_t)D * WOUT_LD * 2 <= WS_ENT && WS_ENT + (size_t)NE * ENT_CAP * 8 <= WS_WD && WS_G2 + (size_t)T * G2_LD * 2 <= WS_U && WS_U + (size_t)T * D * 2 <= WS_END && (size_t)T * XN_LD * 2 <= 256 * MiB, "padded layout");
static_assert(WS_HID + (size_t)HID_ROWS * FF <= WS_SLOT0 && WS_SLOT0 + (size_t)T * D * 2 <= WS_SLOT3 && WS_SLOT3 + (size_t)T * D * 2 <= WS_END, "slot 0 sits between the fp8 hid buffer and slot 3");
static_assert(WS_WD + (size_t)NE * D * FF <= WS_SLOT1 && WS_SLOT1 + (size_t)T * D * 2 <= WS_SLOT2 && WS_SLOT2 + (size_t)T * D * 2 <= WS_HID, "slots 1, 2 sit between the fp8 down weights and the hid buffer");
constexpr size_t DO_XN = 0;
constexpr size_t DO_S = 128 * MiB;
constexpr size_t DO_XC = 0;
constexpr int CW_BAR = 0, CW_GCOUNT = 4096;

constexpr int NWAVES = 8, NTHREADS = 512;
constexpr int LDS_BYTES = 160 * 1024;

struct Args { const float* in[20]; float* out; unsigned char* ws; int ph_lo, ph_hi, pad0, pad1; };

__device__ __forceinline__ unsigned f2bf(float f) { unsigned u = __builtin_bit_cast(unsigned, f); return (u + 0x7fffu + ((u >> 16) & 1u)) >> 16; }
__device__ __forceinline__ unsigned pk2(float lo, float hi) { return f2bf(lo) | (f2bf(hi) << 16); }
__device__ __forceinline__ unsigned pk2_hw(float lo, float hi) { return pk2(lo, hi); }
__device__ __forceinline__ float bflo(unsigned w) { return __builtin_bit_cast(float, w << 16); }
__device__ __forceinline__ float bfhi(unsigned w) { return __builtin_bit_cast(float, w & 0xffff0000u); }
__device__ __forceinline__ float bf2f(bf16 b) { return __builtin_bit_cast(float, ((unsigned)b) << 16); }
__device__ __forceinline__ float wave_sum(float v) {
#pragma unroll
    for (int o = 1; o < 64; o <<= 1) v += __shfl_xor(v, o);
    return v;
}
__device__ __forceinline__ float silu_f(float x) { return x / (1.0f + __expf(-x)); }
__device__ __forceinline__ float silu_fast(float x) { return x * __builtin_amdgcn_rcpf(1.0f + __builtin_amdgcn_exp2f(x * -1.44269504f)); }
__device__ __forceinline__ float softplus_f(float x) { return fmaxf(x, 0.0f) + log1pf(expf(-fabsf(x))); }
__device__ __forceinline__ int lane_id() { return (int)__builtin_amdgcn_mbcnt_hi(~0u, __builtin_amdgcn_mbcnt_lo(~0u, 0u)); }
__device__ __forceinline__ int lane_id_v() { int l; asm volatile("v_mbcnt_lo_u32_b32 %0, -1, 0\n\tv_mbcnt_hi_u32_b32 %0, -1, %0" : "=v"(l)); return l; }
__device__ __forceinline__ float bperm(float v, int src) { return __builtin_bit_cast(float, __builtin_amdgcn_ds_bpermute(src << 2, __builtin_bit_cast(int, v))); }
#define LDS_WAIT() asm volatile("s_waitcnt lgkmcnt(0)" ::: "memory")
#define VM_WAIT() asm volatile("s_waitcnt vmcnt(0)" ::: "memory")

#define XB_TMO      128
#define XB_XCNT(j)  (256  + 64 * (j))
#define XB_XSUB(j)  (1280 + 64 * (j))
#define XB_XGEN(j)  (2304 + 64 * (j))
#define XB_TOP      3328
#define XB_TOPGEN   3392
#define XCD_BAR_WORDS 3456
#define XB_SPIN_CAP (1u << 18)
__device__ __forceinline__ unsigned xb_ld(unsigned* p)              { return __hip_atomic_load(p, __ATOMIC_RELAXED, __HIP_MEMORY_SCOPE_AGENT); }
__device__ __forceinline__ unsigned xb_add(unsigned* p, unsigned v) { return __hip_atomic_fetch_add(p, v, __ATOMIC_RELAXED, __HIP_MEMORY_SCOPE_AGENT); }
__device__ __forceinline__ unsigned xb_xcc_id() { return (unsigned)__builtin_amdgcn_s_getreg((3 << 11) | 20) & 0xFu; }
#define XB_SPIN(cond, bar) do { unsigned _sp = 0; while (cond) { __builtin_amdgcn_s_sleep(1); \
    if ((++_sp & 255u) == 0u) { if (xb_ld(&(bar)[XB_TMO])) break; if (_sp > XB_SPIN_CAP) { atomicAdd(&(bar)[XB_TMO], 1u); break; } } } } while (0)
struct XcdBarrier { unsigned* bar; unsigned x; volatile LAS unsigned* st; int wave; };
__device__ __forceinline__ XcdBarrier xcd_barrier_post(unsigned* bar, volatile LAS unsigned* st, int wave) {
    XcdBarrier b; b.bar = bar; b.x = xb_xcc_id(); b.st = st; b.wave = wave;
    if (wave == 0 && lane_id() == 0) (void)xb_add(&bar[XB_XCNT(b.x)], 1u);
    return b;
}
__device__ __forceinline__ void xcd_barrier_complete(unsigned* bar, unsigned x, unsigned& nloc, unsigned& nx) {
    const unsigned G = gridDim.x * gridDim.y * gridDim.z;
    unsigned sum, cnt, mine, sp = 0u;
    for (;;) {
        sum = 0u; cnt = 0u; mine = 0u;
#pragma unroll
        for (unsigned j = 0; j < 16; ++j) { const unsigned c = xb_ld(&bar[XB_XCNT(j)]); sum += c; cnt += (c > 0u) ? 1u : 0u; mine = (j == x) ? c : mine; }
        if (sum == G) break;
        __builtin_amdgcn_s_sleep(1);
        if ((++sp & 255u) == 0u) { if (xb_ld(&bar[XB_TMO])) break; if (sp > XB_SPIN_CAP) { atomicAdd(&bar[XB_TMO], 1u); break; } }
    }
    nloc = mine > 0u ? mine : 1u; nx = cnt > 0u ? cnt : 1u;
}
__device__ __forceinline__ void xcd_barrier(const XcdBarrier& b) {
    asm volatile("s_waitcnt vmcnt(0)" ::: "memory");
    __syncthreads();
    if (b.wave == 0 && lane_id() == 0) {
        unsigned* bar = b.bar;
        __builtin_amdgcn_s_waitcnt(0);
        unsigned nloc = b.st[0], nx = b.st[1];
        if (nloc == 0u) { xcd_barrier_complete(bar, b.x, nloc, nx); b.st[0] = nloc; b.st[1] = nx; }
        const unsigned old = xb_add(&bar[XB_XSUB(b.x)], 1u);
        const unsigned gen = old / nloc;
        if (old + 1u == (gen + 1u) * nloc) {
            __builtin_amdgcn_fence(__ATOMIC_RELEASE, "agent");
            asm volatile("s_waitcnt vmcnt(0)" ::: "memory");
            const unsigned og = xb_add(&bar[XB_TOP], 1u);
            const unsigned tg = og / nx;
            if (og + 1u == (tg + 1u) * nx) xb_add(&bar[XB_TOPGEN], 1u);
            else XB_SPIN(xb_ld(&bar[XB_TOPGEN]) == tg, bar);
            __builtin_amdgcn_fence(__ATOMIC_ACQUIRE, "agent");
            xb_add(&bar[XB_XGEN(b.x)], 1u);
            asm volatile("s_waitcnt vmcnt(0)" ::: "memory");
        } else {
            XB_SPIN(xb_ld(&bar[XB_XGEN(b.x)]) == gen, bar);
            __builtin_amdgcn_fence(__ATOMIC_ACQUIRE, "agent");
            asm volatile("s_waitcnt vmcnt(0)" ::: "memory");
        }
    }
    __syncthreads();
}

__device__ __forceinline__ void p0_transpose_item(const float* W, int ldsrc, int ksrc0, int nsrc0, bf16* WT, int lddst, int ndst0, int kdst0, LAS float* scr, int lane) {
#pragma unroll 8
    for (int i = 0; i < 32; ++i) { const int kk = 2 * i + (lane >> 5); scr[kk * 33 + (lane & 31)] = W[(size_t)(ksrc0 + kk) * ldsrc + nsrc0 + (lane & 31)]; }
    LDS_WAIT(); asm volatile("" ::: "memory");
    const int c = lane & 7;
#pragma unroll
    for (int j = 0; j < 4; ++j) { const int n = (lane >> 3) + 8 * j; const LAS float* s = scr + (8 * c) * 33 + n;
        v4u o; o.x = pk2(s[0 * 33], s[1 * 33]); o.y = pk2(s[2 * 33], s[3 * 33]); o.z = pk2(s[4 * 33], s[5 * 33]); o.w = pk2(s[6 * 33], s[7 * 33]);
        *(v4u*)(WT + (size_t)(ndst0 + n) * lddst + kdst0 + 8 * c) = o; }
    LDS_WAIT(); asm volatile("" ::: "memory");
}
__device__ __forceinline__ unsigned pk4_fp8(float a, float b, float c, float d);

__device__ __forceinline__ void p0_transpose_item8(const float* W, int ldsrc, int ksrc0, int nsrc0, unsigned char* WT, int lddst, int ndst0, int kdst0, LAS float* scr, int lane) {
#pragma unroll 8
    for (int i = 0; i < 32; ++i) { const int kk = 2 * i + (lane >> 5); scr[kk * 33 + (lane & 31)] = W[(size_t)(ksrc0 + kk) * ldsrc + nsrc0 + (lane & 31)]; }
    LDS_WAIT(); asm volatile("" ::: "memory");
    const int c = lane & 3;
#pragma unroll
    for (int j = 0; j < 2; ++j) { const int n = (lane >> 2) + 16 * j; const LAS float* sp = scr + (16 * c) * 33 + n;
        v4u o; o.x = pk4_fp8(sp[0 * 33] * 32.f, sp[1 * 33] * 32.f, sp[2 * 33] * 32.f, sp[3 * 33] * 32.f); o.y = pk4_fp8(sp[4 * 33] * 32.f, sp[5 * 33] * 32.f, sp[6 * 33] * 32.f, sp[7 * 33] * 32.f);
        o.z = pk4_fp8(sp[8 * 33] * 32.f, sp[9 * 33] * 32.f, sp[10 * 33] * 32.f, sp[11 * 33] * 32.f); o.w = pk4_fp8(sp[12 * 33] * 32.f, sp[13 * 33] * 32.f, sp[14 * 33] * 32.f, sp[15 * 33] * 32.f);
        *(v4u*)(WT + (size_t)(ndst0 + n) * lddst + kdst0 + 16 * c) = o; }
    LDS_WAIT(); asm volatile("" ::: "memory");
}
struct TItem { const float* W; unsigned char* WT; int ldsrc, ksrc0, nsrc0, lddst, ndst0, kdst0, f8; };
__device__ __forceinline__ TItem p0_decode(const Args& a, int it) {
    unsigned char* ws = a.ws; TItem t;
    constexpr int I_IN = 8 * (NPROJ / 64), I_OUT = 16 * 16, I_GU = 8 * 32, I_DN = 8 * 16;
    int r = it;
    if (r < I_IN) { const int kb = r / (NPROJ / 64), nb = r % (NPROJ / 64), nd = 64 * nb;
        int ns = nd < DT_COL0 ? nd : nd + 16;
        if (nd >= 3584) { const int tt = (nd - 3584) >> 8, cc = (nd - 3584) & 255; ns = 16 + (cc < 128 ? 3584 + 128 * tt + cc : 4608 + 128 * tt + (cc - 128)); }
        t = TItem{a.in[I_WIN], ws + WS_WIN, PROJ_DIM, 128 * kb, ns, WIN_LD * 2, nd, 128 * kb * 2, 0}; return t; }
    r -= I_IN;
    if (r < I_OUT) { const int kb = r / 16, nb = r % 16, kd = 128 * kb, ks = (kd + 1024) & 2047;
        t = TItem{a.in[I_WOUT], ws + WS_WOUT, D, ks, 64 * nb, WOUT_LD * 2, 64 * nb, kd * 2, 0}; return t; }
    r -= I_OUT;
    if (r < NE * I_GU) { const int e = r / I_GU, q = r % I_GU, kb = q / 32, nb = q % 32, nd = 64 * nb;
        const int pn = nd >> 8, bj = (nd >> 7) & 1, cc = nd & 127, ns = bj * 1024 + 128 * pn + cc;
        t = TItem{a.in[I_WGU] + (size_t)e * D * 2048, ws + WS_WGU + (size_t)e * 2048 * D, 2048, 128 * kb, ns, D, nd, 128 * kb, 1}; return t; }
    r -= NE * I_GU;
    { const int e = r / I_DN, q = r % I_DN, kb = q / 16, nb = q % 16;
        t = TItem{a.in[I_WD] + (size_t)e * FF * D, ws + WS_WD + (size_t)e * D * FF, D, 128 * kb, 64 * nb, FF, 64 * nb, 128 * kb, 1}; return t; }
}
constexpr int P0_ITEMS_PROJ = 8 * (NPROJ / 64) + 16 * 16;
template <bool MOE>
__device__ __forceinline__ void p0_weights(const Args& a, LAS unsigned char* lds, int gw, int NGW, int wave) {
    const int lane = lane_id_v(), c = lane & 15, h = lane >> 4;
    LAS unsigned char* scr = lds + wave * 16384;
    constexpr int NITEMS = 8 * (NPROJ / 64) + 16 * 16 + NE * 8 * 32 + NE * 8 * 16;
    __syncthreads();
    for (int it = (MOE ? P0_ITEMS_PROJ : 0) + gw; it < (MOE ? NITEMS : P0_ITEMS_PROJ); it += NGW) {
        const TItem t = p0_decode(a, it);
        const float* src = t.W + (size_t)(t.ksrc0 + 4 * h) * t.ldsrc + t.nsrc0 + 4 * c;
        f32x4 v[32];
#pragma unroll
        for (int g = 0; g < 8; ++g)
#pragma unroll
            for (int r = 0; r < 4; ++r) v[4 * g + r] = *(const f32x4*)(src + (size_t)(16 * g + r) * t.ldsrc);
        if (t.f8) {
#pragma unroll
            for (int g = 0; g < 8; ++g)
#pragma unroll
                for (int j = 0; j < 4; ++j)
                    *(LAS unsigned*)(scr + (4 * c + j) * 144 + 16 * g + 4 * h) = pk4_fp8(v[4 * g][j] * 32.f, v[4 * g + 1][j] * 32.f, v[4 * g + 2][j] * 32.f, v[4 * g + 3][j] * 32.f);
            LDS_WAIT(); asm volatile("" ::: "memory");
#pragma unroll
            for (int q = 0; q < 8; ++q) { const int n = 8 * q + (lane >> 3), ch = lane & 7;
                *(v4u*)(t.WT + (size_t)(t.ndst0 + n) * t.lddst + t.kdst0 + 16 * ch) = *(const LAS v4u*)(scr + n * 144 + 16 * ch); }
        } else {
#pragma unroll
            for (int g = 0; g < 8; ++g)
#pragma unroll
                for (int j = 0; j < 4; ++j) { v2u w; w.x = pk2(v[4 * g][j], v[4 * g + 1][j]); w.y = pk2(v[4 * g + 2][j], v[4 * g + 3][j]);
                    *(LAS v2u*)(scr + (4 * c + j) * 256 + 32 * g + 8 * h) = w; }
            LDS_WAIT(); asm volatile("" ::: "memory");
#pragma unroll
            for (int q = 0; q < 16; ++q) { const int n = 4 * q + (lane >> 4), ch = lane & 15;
                *(v4u*)(t.WT + (size_t)(t.ndst0 + n) * t.lddst + t.kdst0 + 16 * ch) = *(const LAS v4u*)(scr + n * 256 + 16 * ch); }
        }
        LDS_WAIT(); asm volatile("" ::: "memory");
    }
}
__device__ __forceinline__ void rms_row_to_bf16(const float* xrow, const float* w, bf16* orow, int lane) {
    const f32x4* xr = (const f32x4*)xrow + lane; const f32x4* wr = (const f32x4*)w + lane;
    f32x4 v[4]; float s = 0.f;
#pragma unroll
    for (int j = 0; j < 4; ++j) { v[j] = xr[64 * j]; s += (v[j].x * v[j].x + v[j].y * v[j].y) + (v[j].z * v[j].z + v[j].w * v[j].w); }
    const float rinv = 1.0f / sqrtf(wave_sum(s) * (1.f / D) + EPS);
    v2u* o8 = (v2u*)orow + lane;
#pragma unroll
    for (int j = 0; j < 4; ++j) { const f32x4 ww = wr[64 * j]; v2u o; o.x = pk2(v[j].x * rinv * ww.x, v[j].y * rinv * ww.y); o.y = pk2(v[j].z * rinv * ww.z, v[j].w * rinv * ww.w); o8[64 * j] = o; }
}
__device__ __forceinline__ void p0_dt_slow(const Args& a, int wg, int G) {
    const int tid = threadIdx.x, rl = tid >> 4, hd = tid & 15;
    const float* x = a.in[I_X]; const float* nw = a.in[I_N1W]; const float* win = a.in[I_WIN] + DT_COL0 + hd;
    float* dt = (float*)(a.ws + WS_DT);
    for (int r0 = wg * 32; r0 < T; r0 += G * 32) {
        const int row = r0 + rl; const float* xr = x + (size_t)row * D;
        float s = 0.f, d = 0.f;
        for (int k = 0; k < D; ++k) { const float xv = xr[k]; s += xv * xv; d += xv * nw[k] * win[(size_t)k * PROJ_DIM]; }
        const float rinv = 1.0f / sqrtf(s * (1.f / D) + EPS);
        dt[row * 16 + hd] = softplus_f(d * rinv + a.in[I_DTB][hd]);
    }
}

constexpr int SG_LD = 132;
template <class ARow>
__device__ __forceinline__ void sg_tile(LAS float* As, LAS float* Bs, const ARow& arow, const bf16* Bt, int ldb, int K, float (&acc)[8][4]) {
    const int t = threadIdx.x, tm = t >> 5, tn = t & 31, lr = t >> 2, kq = t & 3;
    const bf16* ap = arow(lr) + 8 * kq;
    const bf16* bp = Bt + (size_t)lr * ldb + 8 * kq;
#pragma unroll
    for (int i = 0; i < 8; ++i)
#pragma unroll
        for (int j = 0; j < 4; ++j) acc[i][j] = 0.f;
    for (int k0 = 0; k0 < K; k0 += 32) {
        const v4u av = *(const v4u*)(ap + k0), bv = *(const v4u*)(bp + k0);
        __syncthreads();
        { LAS float* pa = As + (8 * kq) * SG_LD + lr; LAS float* pb = Bs + (8 * kq) * SG_LD + lr;
          pa[0 * SG_LD] = bflo(av.x); pa[1 * SG_LD] = bfhi(av.x); pa[2 * SG_LD] = bflo(av.y); pa[3 * SG_LD] = bfhi(av.y);
          pa[4 * SG_LD] = bflo(av.z); pa[5 * SG_LD] = bfhi(av.z); pa[6 * SG_LD] = bflo(av.w); pa[7 * SG_LD] = bfhi(av.w);
          pb[0 * SG_LD] = bflo(bv.x); pb[1 * SG_LD] = bfhi(bv.x); pb[2 * SG_LD] = bflo(bv.y); pb[3 * SG_LD] = bfhi(bv.y);
          pb[4 * SG_LD] = bflo(bv.z); pb[5 * SG_LD] = bfhi(bv.z); pb[6 * SG_LD] = bflo(bv.w); pb[7 * SG_LD] = bfhi(bv.w); }
        __syncthreads();
#pragma unroll 8
        for (int kk = 0; kk < 32; ++kk) {
            const f32x4 a0 = *(const LAS f32x4*)(As + kk * SG_LD + 8 * tm), a1 = *(const LAS f32x4*)(As + kk * SG_LD + 8 * tm + 4);
            const f32x4 b = *(const LAS f32x4*)(Bs + kk * SG_LD + 4 * tn);
            const float av8[8] = {a0.x, a0.y, a0.z, a0.w, a1.x, a1.y, a1.z, a1.w};
#pragma unroll
            for (int i = 0; i < 8; ++i) { acc[i][0] += av8[i] * b.x; acc[i][1] += av8[i] * b.y; acc[i][2] += av8[i] * b.z; acc[i][3] += av8[i] * b.w; }
        }
    }
    __syncthreads();
}

namespace pg8 {
constexpr int BM = 256, BK = 64, HALF = 128, HTB = HALF * BK * 2, STAGE_BYTES = 8 * HTB;
__device__ __forceinline__ int lds_byte(int r, int c) { const int st = (r >> 4) * 2 + (c >> 5), rr = r & 15, cc = c & 31, ob = rr * 64 + cc * 2; return st * 1024 + (ob ^ (((ob >> 9) & 1) << 5)); }
__device__ __forceinline__ void stage_rc(int b, int& R, int& C) { const int st = b / 1024, sb = b % 1024, swz = sb ^ (((sb >> 9) & 1) << 5); R = (st >> 1) * 16 + swz / 64; C = (st & 1) * 32 + (swz % 64) / 2; }
__device__ __forceinline__ int perm32(int rho) { const int n = rho >> 4, i = rho & 15; return 8 * (i >> 2) + 4 * n + (i & 3); }
struct Unit { int pm, pn, aux; };
typedef int v8i __attribute__((ext_vector_type(8)));
typedef int v4i __attribute__((ext_vector_type(4)));
template <class Epi, class Sched, bool ALIGN_EPI, bool F8 = false>
__device__ __forceinline__ void gemm_phase(LAS unsigned char* lds, const char* Abase, const int K, const Sched& S, const Epi& E, const int wid) {
    const int lane = lane_id(), tid = wid * 64 + lane, wr = wid >> 2, wc = wid & 3, fr = lane & 15, fq = lane >> 4;
    const int nt = K / BK;
    unsigned voffB[2];
#pragma unroll
    for (int i = 0; i < 2; ++i) { int R_, C_; stage_rc(tid * 16 + i * 8192, R_, C_); const int Rb = Epi::PERM ? ((R_ & ~31) + perm32(R_ & 31)) : R_; voffB[i] = (unsigned)Rb * S.ldbB + (unsigned)C_ * 2u; }
    const size_t kstep = (size_t)(BK * 2), hstepB = (size_t)HALF * S.ldbB;
    const unsigned ldsw = (unsigned)wid * 1024u;
    const int aoff = lds_byte(wr * 64 + fr, fq * 8), boff = lds_byte(wc * 32 + fr, fq * 8);
#define PG8_SA(b, h) (((b) * 2 + (h)) * HTB)
#define PG8_SB(b, h) ((4 + (b) * 2 + (h)) * HTB)
#define PG8_STAGE(bufoff, gbase, voff) do { _Pragma("unroll") for (int _i = 0; _i < 2; ++_i) \
        __builtin_amdgcn_global_load_lds((const unsigned*)((const char*)(gbase) + (voff)[_i]), (LAS unsigned*)(lds + (bufoff) + ldsw + _i * 8192), 16, 0, 0); } while (0)
#define PG8_LDA(dst, b, h) do { _Pragma("unroll") for (int m = 0; m < 4; ++m) { if constexpr (F8) { dst##8[m].lo = *(const LAS v4i*)(lds + PG8_SA(b, h) + aoff + m * 2048); dst##8[m].hi = *(const LAS v4i*)(lds + PG8_SA(b, h) + aoff + m * 2048 + 1024); } \
        else { _Pragma("unroll") for (int k = 0; k < 2; ++k) dst[m][k] = *(const LAS bf16x8*)(lds + PG8_SA(b, h) + aoff + m * 2048 + k * 1024); } } } while (0)
#define PG8_LDB(dst, b, h) do { _Pragma("unroll") for (int n = 0; n < 2; ++n) { if constexpr (F8) { dst##8[n].lo = *(const LAS v4i*)(lds + PG8_SB(b, h) + boff + n * 2048); dst##8[n].hi = *(const LAS v4i*)(lds + PG8_SB(b, h) + boff + n * 2048 + 1024); } \
        else { _Pragma("unroll") for (int k = 0; k < 2; ++k) dst[n][k] = *(const LAS bf16x8*)(lds + PG8_SB(b, h) + boff + n * 2048 + k * 1024); } } } while (0)
#define PG8_MMA(ai, bj, At, Bt) do { __builtin_amdgcn_s_setprio(1); _Pragma("unroll") for (int m = 0; m < 4; ++m) _Pragma("unroll") for (int n = 0; n < 2; ++n) { \
        if constexpr (F8) asm volatile("v_mfma_scale_f32_16x16x128_f8f6f4 %0, %1, %2, %0, %3, %3 op_sel_hi:[0,0,0]" : "+v"(acc[ai][bj][m][n]) : "v"(Bt##8[n]), "v"(At##8[m]), "v"(one_scale));   \
        else { _Pragma("unroll") for (int k = 0; k < 2; ++k) acc[ai][bj][m][n] = __builtin_amdgcn_mfma_f32_16x16x32_bf16(Bt[n][k], At[m][k], acc[ai][bj][m][n], 0, 0, 0); } } \
        __builtin_amdgcn_s_setprio(0); } while (0)
#define PG8_WAIT_V(n) asm volatile("s_waitcnt vmcnt(" #n ")" ::: "memory")
#define PG8_WAIT_L(n) asm volatile("s_waitcnt lgkmcnt(" #n ")" ::: "memory")
#define PG8_WAIT_V8S do { if (post_epi) asm volatile("s_waitcnt vmcnt(%0)" :: "n"(8 + Epi::NST) : "memory"); else asm volatile("s_waitcnt vmcnt(8)" ::: "memory"); } while (0)
#define PG8_BAR __builtin_amdgcn_s_barrier()
#define PG8_SCHED __builtin_amdgcn_sched_barrier(0)
    Unit cur, nxt; int ui = 0;
    if (!S.next(0, cur)) return;
    f32x4 acc[2][2][4][2];
#pragma unroll
    for (int a = 0; a < 2; ++a)
#pragma unroll
        for (int b = 0; b < 2; ++b)
#pragma unroll
            for (int m = 0; m < 4; ++m)
#pragma unroll
                for (int n = 0; n < 2; ++n) acc[a][b][m][n] = (f32x4){0.f, 0.f, 0.f, 0.f};
    bf16x8 At[4][2], B0[2][2], B1[2][2]; v8i At8[4], B08[2], B18[2]; const int one_scale = 0x7f7f7f7f;
    unsigned cA0[2], cA1[2], nA0[2], nA1[2];
    S.a_offs(cur, tid, cA0, cA1);
    const char* cB = S.b_base(cur);
    PG8_STAGE(PG8_SB(0, 0), cB, voffB); PG8_STAGE(PG8_SB(0, 1), cB + hstepB, voffB); PG8_STAGE(PG8_SA(0, 0), Abase, cA0); PG8_STAGE(PG8_SA(0, 1), Abase, cA1);
    if (wr == 1) PG8_BAR;
    PG8_WAIT_V(2); PG8_BAR;
    PG8_STAGE(PG8_SB(1, 0), cB + kstep, voffB); PG8_STAGE(PG8_SA(1, 0), Abase + kstep, cA0); PG8_STAGE(PG8_SB(1, 1), cB + hstepB + kstep, voffB);
    PG8_WAIT_V(6); PG8_BAR;
    for (;;) {
        const bool has_next = S.next(ui + 1, nxt);
        const char* nB = cB;
        if (has_next) { S.a_offs(nxt, tid, nA0, nA1); nB = S.b_base(nxt); } else { nA0[0] = cA0[0]; nA0[1] = cA0[1]; nA1[0] = cA1[0]; nA1[1] = cA1[1]; }
#pragma unroll 1
        for (int t = 0; t < nt; t += 2) {
            const bool last = (t == nt - 2);
            const bool post_epi = (t == 0) && (ui > 0);
            if (last) E.dma(cur, lds + 135168, wid, tid & 63);
            const char* a1 = Abase + (size_t)(t + 1) * kstep;
            const char* a2 = last ? Abase : Abase + (size_t)(t + 2) * kstep; const char* b2 = last ? nB : cB + (size_t)(t + 2) * kstep;
            const char* a3 = a2 + kstep; const char* b3 = b2 + kstep;
            unsigned x0[2], x1[2];
            x0[0] = last ? nA0[0] : cA0[0]; x0[1] = last ? nA0[1] : cA0[1]; x1[0] = last ? nA1[0] : cA1[0]; x1[1] = last ? nA1[1] : cA1[1];
            PG8_LDB(B0, 0, 0); PG8_LDB(B1, 0, 1); PG8_SCHED; PG8_LDA(At, 0, 0); PG8_STAGE(PG8_SA(1, 1), a1, cA1);
            PG8_WAIT_V8S; PG8_BAR; PG8_MMA(0, 0, At, B0); PG8_MMA(0, 1, At, B1); PG8_BAR; PG8_SCHED;
            PG8_LDA(At, 0, 1); PG8_STAGE(PG8_SB(0, 0), b2, voffB); PG8_STAGE(PG8_SB(0, 1), b2 + hstepB, voffB); PG8_STAGE(PG8_SA(0, 0), a2, x0);
            PG8_WAIT_V8S; PG8_BAR; PG8_MMA(1, 0, At, B0); PG8_MMA(1, 1, At, B1); PG8_BAR; PG8_SCHED;
            PG8_LDB(B0, 1, 0); PG8_LDB(B1, 1, 1); PG8_SCHED; PG8_LDA(At, 1, 0); PG8_STAGE(PG8_SA(0, 1), a2, x1);
            PG8_WAIT_V(8); PG8_BAR; PG8_MMA(0, 0, At, B0); PG8_MMA(0, 1, At, B1); PG8_BAR; PG8_SCHED;
            PG8_LDA(At, 1, 1); PG8_STAGE(PG8_SB(1, 0), b3, voffB); PG8_STAGE(PG8_SB(1, 1), b3 + hstepB, voffB); PG8_STAGE(PG8_SA(1, 0), a3, x0);
            PG8_WAIT_V(8); PG8_BAR; PG8_MMA(1, 0, At, B0); PG8_MMA(1, 1, At, B1); PG8_BAR; PG8_SCHED;
        }
        if constexpr (ALIGN_EPI) { if (wr == 0) PG8_BAR; }
        if constexpr (F8) asm volatile("s_nop 15\n\ts_nop 15" ::: "memory");
        E(acc, cur, wr, wc, fr, fq, lds + 135168);
        if (!has_next) break;
#pragma unroll
        for (int a = 0; a < 2; ++a)
#pragma unroll
            for (int b = 0; b < 2; ++b)
#pragma unroll
                for (int m = 0; m < 4; ++m)
#pragma unroll
                    for (int n = 0; n < 2; ++n) acc[a][b][m][n] = (f32x4){0.f, 0.f, 0.f, 0.f};
        cur = nxt; cB = nB; cA0[0] = nA0[0]; cA0[1] = nA0[1]; cA1[0] = nA1[0]; cA1[1] = nA1[1]; ++ui;
        if constexpr (ALIGN_EPI) { if (wr == 1) PG8_BAR; }
    }
    PG8_WAIT_V(0);
    if constexpr (!ALIGN_EPI) { if (wr == 0) PG8_BAR; }
    PG8_BAR;
#undef PG8_SA
#undef PG8_SB
#undef PG8_STAGE
#undef PG8_LDA
#undef PG8_LDB
#undef PG8_MMA
#undef PG8_WAIT_V
#undef PG8_WAIT_L
#undef PG8_WAIT_V8S
#undef PG8_BAR
#undef PG8_SCHED
}
__device__ __forceinline__ unsigned cvt_pk_bf16(float lo, float hi) { unsigned r; asm volatile("v_cvt_pk_bf16_f32 %0, %1, %2" : "=v"(r) : "v"(lo), "v"(hi)); return r; }

struct DenseSched {
    int nM, nN, nwg, G, c, GS = 8; bool rev = false; unsigned lda2, ldbB;
    __device__ __forceinline__ void init(int M, int N, int G_, int c_, int lda) { nM = M / BM; nN = N / BM; nwg = nM * nN; G = G_; c = c_; lda2 = (unsigned)lda * 2u; }
    __device__ __forceinline__ bool next(int i, Unit& u) const {
        const long L = (long)i * G + c; if (L >= nwg) return false;
        int wgid = (int)L; { const int q = nwg / 8, r = nwg % 8, xcd = wgid % 8, off = wgid / 8; wgid = (xcd < r ? xcd * (q + 1) : r * (q + 1) + (xcd - r) * q) + off; }
        if (rev) wgid = nwg - 1 - wgid;
        const int nig = GS * nN, gid = wgid / nig, fm = gid * GS, gsz = (nM - fm) < GS ? (nM - fm) : GS;
        u.pm = fm + ((wgid % nig) % gsz); u.pn = (wgid % nig) / gsz; u.aux = 0; return true;
    }
    const char* Bt; size_t tstepB;
    __device__ __forceinline__ void a_offs(const Unit& u, int tid, unsigned (&o0)[2], unsigned (&o1)[2]) const {
        int R[2], C[2]; stage_rc(tid * 16, R[0], C[0]); stage_rc(tid * 16 + 8192, R[1], C[1]);
#pragma unroll
        for (int i = 0; i < 2; ++i) { o0[i] = (unsigned)(u.pm * BM + R[i]) * lda2 + (unsigned)C[i] * 2u; o1[i] = o0[i] + 128u * lda2; }
    }
    __device__ __forceinline__ const char* b_base(const Unit& u) const { return Bt + (size_t)u.pn * tstepB; }
};
}

__device__ __forceinline__ bf16* proj_ptr(unsigned char* ws, int row, int n) {
    if (n < 1024) return (bf16*)(ws + WS_Z) + (size_t)row * 1024 + n;
    if (n < 2560) return (bf16*)(ws + WS_XBC) + (size_t)row * DXBC + (n - 1024);
    if (n < 4608) return (bf16*)(ws + WS_G2) + (size_t)row * 2048 + (n - 2560);
    return (bf16*)(ws + WS_U) + (size_t)row * 1024 + (n - 4608);
}
__device__ __forceinline__ void p1_slow(const Args& a, LAS unsigned char* lds, int wg, int G) {
    LAS float* As = (LAS float*)lds; LAS float* Bs = As + 32 * SG_LD;
    const bf16* xn = (const bf16*)((unsigned char*)a.out + DO_XN); const bf16* wt = (const bf16*)(a.ws + WS_WIN);
    const int t = threadIdx.x, tm = t >> 5, tn = t & 31;
    for (int it = wg; it < (T / 128) * (NPROJ / 128); it += G) {
        const int mt = it / (NPROJ / 128), nt = it % (NPROJ / 128);
        float acc[8][4];
        auto arow = [&](int r) { return xn + (size_t)(mt * 128 + r) * D; };
        sg_tile(As, Bs, arow, wt + (size_t)nt * 128 * D, D, D, acc);
#pragma unroll
        for (int i = 0; i < 8; ++i) { v2u o; o.x = pk2(acc[i][0], acc[i][1]); o.y = pk2(acc[i][2], acc[i][3]);
            *(v2u*)proj_ptr(a.ws, mt * 128 + 8 * tm + i, nt * 128 + 4 * tn) = o; }
    }
}

__device__ __forceinline__ void ssd_conv_slow(const Args& a, int wg, int G) {
    const bf16* xbc = (const bf16*)(a.ws + WS_XBC); bf16* xc = (bf16*)((unsigned char*)a.out + DO_XC);
    const float* cw = a.in[I_SCW]; const float* cb = a.in[I_SCB];
    for (size_t i = (size_t)wg * NTHREADS + threadIdx.x; i < (size_t)T * (DXBC / 4); i += (size_t)G * NTHREADS) {
        const int row = (int)(i / (DXBC / 4)), c = 4 * (int)(i % (DXBC / 4)), tl = row % SEQ;
        float s[4] = {cb[c], cb[c + 1], cb[c + 2], cb[c + 3]};
#pragma unroll
        for (int k = 0; k < 4; ++k) { const int tt = tl - 3 + k; if (tt < 0) continue;
            const v2u v = *(const v2u*)(xbc + (size_t)(row - 3 + k) * DXBC + c);
            s[0] += cw[k * DXBC + c] * bflo(v.x); s[1] += cw[k * DXBC + c + 1] * bfhi(v.x); s[2] += cw[k * DXBC + c + 2] * bflo(v.y); s[3] += cw[k * DXBC + c + 3] * bfhi(v.y); }
        v2u o; o.x = pk2(silu_f(s[0]), silu_f(s[1])); o.y = pk2(silu_f(s[2]), silu_f(s[3]));
        *(v2u*)(xc + (size_t)row * DXBC + c) = o;
    }
}
__device__ __forceinline__ void ssd_rec_slow(const Args& a, LAS unsigned char* lds, int wg) {
    if (wg >= NBATCH * NH) return;
    const int b = wg >> 4, h = wg & 15, g = h >> 3, tid = threadIdx.x, lane = tid & 63;
    const bf16* xc = (const bf16*)((unsigned char*)a.out + DO_XC); const float* dt = (const float*)(a.ws + WS_DT);
    bf16* g2 = (bf16*)(a.ws + WS_G2);
    LAS float* Bc = (LAS float*)lds; LAS float* Cc = Bc + 64 * 128;
    const float A = -expf(a.in[I_ALOG][h]), Dh = a.in[I_DSKIP][h];
    float st[128];
#pragma unroll
    for (int n = 0; n < 128; ++n) st[n] = 0.f;
    for (int t0 = 0; t0 < SEQ; t0 += 64) {
        __syncthreads();
        { const int tt = tid >> 3, seg = tid & 7; const size_t row = (size_t)b * SEQ + t0 + tt;
          const bf16* pb = xc + row * DXBC + 1024 + 128 * g + 16 * seg; const bf16* pc = xc + row * DXBC + 1280 + 128 * g + 16 * seg;
#pragma unroll
          for (int q = 0; q < 2; ++q) { const v4u vb = *(const v4u*)(pb + 8 * q), vc = *(const v4u*)(pc + 8 * q);
              LAS float* ob = Bc + tt * 128 + 16 * seg + 8 * q; LAS float* oc = Cc + tt * 128 + 16 * seg + 8 * q;
              ob[0] = bflo(vb.x); ob[1] = bfhi(vb.x); ob[2] = bflo(vb.y); ob[3] = bfhi(vb.y); ob[4] = bflo(vb.z); ob[5] = bfhi(vb.z); ob[6] = bflo(vb.w); ob[7] = bfhi(vb.w);
              oc[0] = bflo(vc.x); oc[1] = bfhi(vc.x); oc[2] = bflo(vc.y); oc[3] = bfhi(vc.y); oc[4] = bflo(vc.z); oc[5] = bfhi(vc.z); oc[6] = bflo(vc.w); oc[7] = bfhi(vc.w); } }
        __syncthreads();
        if (tid < 64) {
            for (int tt = 0; tt < 64; ++tt) {
                const size_t row = (size_t)b * SEQ + t0 + tt;
                const float dtv = dt[row * 16 + h], x = bf2f(xc[row * DXBC + h * 64 + lane]);
                const float dec = expf(dtv * A), xd = dtv * x; float y = 0.f;
#pragma unroll
                for (int n4 = 0; n4 < 32; ++n4) { const f32x4 bv = *(const LAS f32x4*)(Bc + tt * 128 + 4 * n4), cv = *(const LAS f32x4*)(Cc + tt * 128 + 4 * n4);
                    st[4 * n4 + 0] = st[4 * n4 + 0] * dec + xd * bv.x; y += st[4 * n4 + 0] * cv.x;
                    st[4 * n4 + 1] = st[4 * n4 + 1] * dec + xd * bv.y; y += st[4 * n4 + 1] * cv.y;
                    st[4 * n4 + 2] = st[4 * n4 + 2] * dec + xd * bv.z; y += st[4 * n4 + 2] * cv.z;
                    st[4 * n4 + 3] = st[4 * n4 + 3] * dec + xd * bv.w; y += st[4 * n4 + 3] * cv.w; }
                y += Dh * x;
                g2[row * 2048 + 1024 + h * 64 + lane] = (bf16)f2bf(y);
            }
        }
    }
}
__device__ __forceinline__ void ssd_norm_slow(const Args& a, int gw, int NGW, int lane) {
    bf16* g2 = (bf16*)(a.ws + WS_G2); const bf16* z = (const bf16*)(a.ws + WS_Z); const float* nw = a.in[I_SNW];
    for (int it = gw; it < T * NG; it += NGW) {
        const int row = it >> 1, g = it & 1, ch = 512 * g + 8 * lane;
        bf16* yp = g2 + (size_t)row * 2048 + 1024 + ch;
        const v4u yv = *(const v4u*)yp, zv = *(const v4u*)(z + (size_t)row * 1024 + ch);
        float gg[8]; const unsigned yw[4] = {yv.x, yv.y, yv.z, yv.w}, zw[4] = {zv.x, zv.y, zv.z, zv.w}; float ss = 0.f;
#pragma unroll
        for (int j = 0; j < 4; ++j) { gg[2 * j] = bflo(yw[j]) * silu_f(bflo(zw[j])); gg[2 * j + 1] = bfhi(yw[j]) * silu_f(bfhi(zw[j])); ss += gg[2 * j] * gg[2 * j] + gg[2 * j + 1] * gg[2 * j + 1]; }
        const float rinv = 1.0f / sqrtf(wave_sum(ss) * (1.f / 512.f) + EPS);
        v4u o; o.x = pk2(gg[0] * rinv * nw[ch], gg[1] * rinv * nw[ch + 1]); o.y = pk2(gg[2] * rinv * nw[ch + 2], gg[3] * rinv * nw[ch + 3]);
        o.z = pk2(gg[4] * rinv * nw[ch + 4], gg[5] * rinv * nw[ch + 5]); o.w = pk2(gg[6] * rinv * nw[ch + 6], gg[7] * rinv * nw[ch + 7]);
        *(v4u*)yp = o;
    }
}


constexpr int SS_ACUM = 0, SS_E2 = 4096, SS_EI = 8192, SS_R = 12288, SS_SSUM = 12416, SS_C = 16896, SS_CB = 51712, SS_X = 86528;
constexpr int SS_LD = 272, SS_XLD = 144;
static_assert(SS_X + 512 * SS_XLD <= LDS_BYTES - 64 && SS_C + 128 * SS_LD <= SS_CB && SS_CB + 128 * SS_LD <= SS_X, "SSD LDS map");
typedef float f32x4v __attribute__((ext_vector_type(4)));
__device__ __forceinline__ void unpack8(const v4u v, float* f);
__device__ __forceinline__ float wave_incl_scan(float v, int lane) {
#pragma unroll
    for (int o = 1; o < 64; o <<= 1) { const float t = bperm(v, lane >= o ? lane - o : lane); if (lane >= o) v += t; }
    return v;
}
template <int MODE>
__device__ __forceinline__ void ssd_tables(const Args& a, LAS unsigned char* lds, int b, int c, int g, int wave, int lane) {
    const float* dt = (const float*)(a.ws + WS_DT); const int h = 8 * g + wave; const float A = -expf(a.in[I_ALOG][h]);
    const size_t row0 = (size_t)b * SEQ + (size_t)c * CHK;
    const float d0 = dt[(row0 + 2 * lane) * 16 + h], d1 = dt[(row0 + 2 * lane + 1) * 16 + h];
    const float s1 = (d0 + d1) * A, incl = wave_incl_scan(s1, lane), ex = incl - s1;
    const float a0 = ex + d0 * A, a1 = incl, tot = bperm(incl, lane | 63);
    LAS float* acum = (LAS float*)(lds + SS_ACUM) + wave * 128; LAS float* e2 = (LAS float*)(lds + SS_E2) + wave * 128; LAS float* ei = (LAS float*)(lds + SS_EI) + wave * 128;
    acum[2 * lane] = a0; acum[2 * lane + 1] = a1;
    if (MODE == 0) { e2[2 * lane] = d0 * __expf(tot - a0); e2[2 * lane + 1] = d1 * __expf(tot - a1);
        if (lane == 0) ((float*)(a.ws + WS_CDEC))[((size_t)b * NCHK + c) * NH + h] = __expf(tot); }
    else {
        const float Rb = bperm(ex, lane & 48);
        e2[2 * lane] = d0 * __expf(fminf(Rb - a0, 80.f)); e2[2 * lane + 1] = d1 * __expf(fminf(Rb - a1, 80.f));
        ei[2 * lane] = __expf(a0); ei[2 * lane + 1] = __expf(a1);
        if ((lane & 15) == 0) ((LAS float*)(lds + SS_R))[wave * 4 + (lane >> 4)] = Rb; }
}
template <bool TRANS, bool SCALE>
__device__ __forceinline__ void conv_stage(const Args& a, LAS unsigned char* dst, int strideB, int b, int c, int col0, int nq, int t0, int ntb, const LAS float* scale, int wave) {
    const bf16* xbc = (const bf16*)(a.ws + WS_XBC); const float* cw = a.in[I_SCW]; const float* cb = a.in[I_SCB];
    const int tid_ = wave * 64 + lane_id_v();
    const int qd = tid_ % nq, ch = col0 + 4 * qd;
    const f32x4 w0 = *(const f32x4*)(cw + ch), w1 = *(const f32x4*)(cw + DXBC + ch), w2 = *(const f32x4*)(cw + 2 * DXBC + ch), w3 = *(const f32x4*)(cw + 3 * DXBC + ch), bs = *(const f32x4*)(cb + ch);
    for (int tb = tid_ / nq; tb < ntb; tb += NTHREADS / nq) {
        const int tl = t0 + 8 * tb, tab0 = c * CHK + tl;
        const bf16* src = xbc + ((size_t)b * SEQ + tab0) * DXBC + ch;
        v2u pin[11];
#pragma unroll
        for (int r = 0; r < 11; ++r) pin[r] = *(const v2u*)(src + (ptrdiff_t)((c > 0 || tl + r >= 3) ? r - 3 : 0) * DXBC);
        if (c == 0) {
#pragma unroll
            for (int r = 0; r < 3; ++r) if (tl + r < 3) pin[r] = (v2u){0u, 0u}; }
        if (TRANS) {
#pragma unroll
            for (int q = 0; q < 4; ++q) {
                float x[11];
#pragma unroll
                for (int r = 0; r < 11; ++r) { const unsigned wd = (q < 2) ? pin[r].x : pin[r].y; x[r] = (q & 1) ? bfhi(wd) : bflo(wd); }
                float o[8];
#pragma unroll
                for (int tt = 0; tt < 8; ++tt) { float v = bs[q] + w0[q] * x[tt] + w1[q] * x[tt + 1] + w2[q] * x[tt + 2] + w3[q] * x[tt + 3]; v = silu_fast(v); if (SCALE) v *= scale[((ch - col0) >> 6) * 128 + tl + tt]; o[tt] = v; }
                v4u w; w.x = pk2_hw(o[0], o[1]); w.y = pk2_hw(o[2], o[3]); w.z = pk2_hw(o[4], o[5]); w.w = pk2_hw(o[6], o[7]);
                *(LAS v4u*)(dst + (ch - col0 + q) * strideB + (tl - t0) * 2) = w; }
        } else {
#pragma unroll
            for (int tt = 0; tt < 8; ++tt) { float o[4];
#pragma unroll
                for (int q = 0; q < 4; ++q) { float xx[4];
#pragma unroll
                    for (int k = 0; k < 4; ++k) { const unsigned wd = (q < 2) ? pin[tt + k].x : pin[tt + k].y; xx[k] = (q & 1) ? bfhi(wd) : bflo(wd); }
                    o[q] = silu_fast(bs[q] + w0[q] * xx[0] + w1[q] * xx[1] + w2[q] * xx[2] + w3[q] * xx[3]); }
                v2u w; w.x = pk2_hw(o[0], o[1]); w.y = pk2_hw(o[2], o[3]); *(LAS v2u*)(dst + (tl - t0 + tt) * strideB + (ch - col0) * 2) = w; }
        }
    }
}
#define MFMA16(A_, B_, C_) __builtin_amdgcn_mfma_f32_16x16x32_bf16((A_), (B_), (C_), 0, 0, 0)
__device__ __forceinline__ void ssd_state_phase(const Args& a, LAS unsigned char* lds, int wg, int G, int wave) {
    bf16* S = (bf16*)((unsigned char*)a.out + DO_S);
    for (int u = wg; u < NBATCH * NCHK * NG; u += G) {
        const int g = u & 1, c = (u >> 1) & (NCHK - 1), b = u >> 7;
        const int lane = lane_id_v(); const int r = lane & 15, q = lane >> 4;
        __syncthreads();
        ssd_tables<0>(a, lds, b, c, g, wave, lane);
        conv_stage<true, false>(a, lds + SS_C, SS_LD, b, c, 1024 + 128 * g, 32, 0, 16, nullptr, wave);
        __syncthreads();
        f32x4 acc[8][4];
#pragma unroll
        for (int nt = 0; nt < 8; ++nt)
#pragma unroll
            for (int pt = 0; pt < 4; ++pt) acc[nt][pt] = (f32x4){0.f, 0.f, 0.f, 0.f};
        LAS unsigned char* BT = lds + SS_C; LAS unsigned char* XT = lds + SS_X;
        for (int jh = 0; jh < 2; ++jh) {
            if (jh) __syncthreads();
            conv_stage<true, true>(a, XT, SS_XLD, b, c, 512 * g, 128, 64 * jh, 8, (const LAS float*)(lds + SS_E2), wave);
            __syncthreads();
#pragma unroll
            for (int kk = 0; kk < 2; ++kk) { const int ks = 2 * jh + kk;
                bf16x8 xb[4];
#pragma unroll
                for (int pt = 0; pt < 4; ++pt) xb[pt] = *(const LAS bf16x8*)(XT + (64 * wave + 16 * pt + r) * SS_XLD + (32 * kk + 8 * q) * 2);
#pragma unroll
                for (int nt = 0; nt < 8; ++nt) { const bf16x8 bt = *(const LAS bf16x8*)(BT + (64 * (nt >> 2) + 16 * (r >> 2) + 4 * (nt & 3) + (r & 3)) * SS_LD + (32 * ks + 8 * q) * 2);
#pragma unroll
                    for (int pt = 0; pt < 4; ++pt) acc[nt][pt] = MFMA16(bt, xb[pt], acc[nt][pt]); }
            }
        }
        bf16* Sp = S + ((((size_t)b * NCHK + c) * NH + 8 * g + wave) * 64) * 128;
#pragma unroll
        for (int G4 = 0; G4 < 2; ++G4)
#pragma unroll
            for (int pt = 0; pt < 4; ++pt) { const f32x4 a0 = acc[4 * G4][pt], a1 = acc[4 * G4 + 1][pt], a2 = acc[4 * G4 + 2][pt], a3 = acc[4 * G4 + 3][pt];
                v4u o0, o1; o0.x = pk2(a0[0], a0[1]); o0.y = pk2(a0[2], a0[3]); o0.z = pk2(a1[0], a1[1]); o0.w = pk2(a1[2], a1[3]);
                o1.x = pk2(a2[0], a2[1]); o1.y = pk2(a2[2], a2[3]); o1.z = pk2(a3[0], a3[1]); o1.w = pk2(a3[2], a3[3]);
                bf16* dp = Sp + (16 * pt + r) * 128 + 64 * G4 + 16 * q; *(v4u*)dp = o0; *(v4u*)(dp + 8) = o1; }
    }
}
__device__ __forceinline__ void ssd_scan_phase(const Args& a, int wg, int G, int wave) {
    bf16* S = (bf16*)((unsigned char*)a.out + DO_S); const float* cdec = (const float*)(a.ws + WS_CDEC);
    for (int gid0 = wg * NTHREADS + wave * 64; gid0 < NBATCH * NH * 1024; gid0 += G * NTHREADS) {
        const int gid = gid0 + lane_id_v();
        const int bh = __builtin_amdgcn_readfirstlane(gid0 >> 10), e8 = gid & 1023, b = bh >> 4, h = bh & 15;
        float st[8];
#pragma unroll
        for (int j = 0; j < 8; ++j) st[j] = 0.f;
        bf16* Sp = S + ((size_t)b * NCHK * NH + h) * 8192 + 8 * e8; const float* dcp = cdec + (size_t)b * NCHK * NH + h;
        v4u sa[16], sb[16];
#define SCAN_LOAD(arr, c) _Pragma("unroll") for (int k_ = 0; k_ < 16; ++k_) arr[k_] = *(const v4u*)(Sp + (size_t)(16 * (c) + k_) * NH * 8192);
#define SCAN_COMP(arr, c) _Pragma("unroll") for (int k_ = 0; k_ < 16; ++k_) { const int ch = 16 * (c) + k_; const float dc = dcp[(size_t)ch * NH]; \
            v4u o; o.x = pk2(st[0], st[1]); o.y = pk2(st[2], st[3]); o.z = pk2(st[4], st[5]); o.w = pk2(st[6], st[7]); *(v4u*)(Sp + (size_t)ch * NH * 8192) = o; \
            float f[8]; unpack8(arr[k_], f); \
            _Pragma("unroll") for (int j = 0; j < 8; ++j) st[j] = st[j] * dc + f[j]; }
        static_assert(NCHK == 64, "scan unrolled for 64 chunks");
        SCAN_LOAD(sa, 0) SCAN_LOAD(sb, 1)
        SCAN_COMP(sa, 0) SCAN_LOAD(sa, 2)
        SCAN_COMP(sb, 1) SCAN_LOAD(sb, 3)
        SCAN_COMP(sa, 2) SCAN_COMP(sb, 3)
#undef SCAN_LOAD
#undef SCAN_COMP
    }
}
__device__ __forceinline__ void ssd_out_phase(const Args& a, LAS unsigned char* lds, int wg, int G, int wave) {
    const bf16* H = (const bf16*)((const unsigned char*)a.out + DO_S); const bf16* Z = (const bf16*)(a.ws + WS_Z); bf16* g2 = (bf16*)(a.ws + WS_G2);
    LAS unsigned char* Cl = lds + SS_C; LAS unsigned char* CBl = lds + SS_CB; LAS unsigned char* Bl = lds + SS_X; LAS unsigned char* XT = lds + SS_X;
    for (int u = wg; u < NBATCH * NCHK * NG; u += G) {
        const int g = u & 1, c = (u >> 1) & (NCHK - 1), b = u >> 7, h = 8 * g + wave;
        const int lane = lane_id_v(); const int r = lane & 15, q = lane >> 4;
        __syncthreads();
        ssd_tables<1>(a, lds, b, c, g, wave, lane);
        bf16x8 hf[4][4];
        { const bf16* Hp = H + ((((size_t)b * NCHK + c) * NH + h) * 64) * 128 + (16 * (r >> 2) + (r & 3)) * 128 + 8 * q;
#pragma unroll
          for (int ks = 0; ks < 4; ++ks)
#pragma unroll
              for (int pt = 0; pt < 4; ++pt) hf[ks][pt] = *(const bf16x8*)(Hp + 4 * pt * 128 + 32 * ks); }
        conv_stage<false, false>(a, Cl, SS_LD, b, c, 1280 + 128 * g, 32, 0, 16, nullptr, wave);
        conv_stage<false, false>(a, Bl, SS_LD, b, c, 1024 + 128 * g, 32, 0, 16, nullptr, wave);
        __syncthreads();
        { bf16x8 cf[4];
#pragma unroll
          for (int ks = 0; ks < 4; ++ks) cf[ks] = *(const LAS bf16x8*)(Cl + (16 * wave + r) * SS_LD + (32 * ks + 8 * q) * 2);
          for (int jt = 0; jt <= wave; ++jt) { f32x4 d = (f32x4){0.f, 0.f, 0.f, 0.f};
#pragma unroll
              for (int ks = 0; ks < 4; ++ks) { const bf16x8 bf = *(const LAS bf16x8*)(Bl + (16 * jt + r) * SS_LD + (32 * ks + 8 * q) * 2); d = MFMA16(bf, cf[ks], d); }
              v2u w; w.x = pk2(d[0], d[1]); w.y = pk2(d[2], d[3]); *(LAS v2u*)(CBl + (16 * wave + r) * SS_LD + (16 * jt + 4 * q) * 2) = w; } }
        f32x4 acc[8][4];
#pragma unroll
        for (int it = 0; it < 8; ++it)
#pragma unroll
            for (int pt = 0; pt < 4; ++pt) acc[it][pt] = (f32x4){0.f, 0.f, 0.f, 0.f};
#pragma unroll
        for (int ks = 0; ks < 4; ++ks) {
#pragma unroll
            for (int it = 0; it < 8; ++it) { const bf16x8 cf = *(const LAS bf16x8*)(Cl + (16 * it + r) * SS_LD + (32 * ks + 8 * q) * 2);
#pragma unroll
                for (int pt = 0; pt < 4; ++pt) acc[it][pt] = MFMA16(hf[ks][pt], cf, acc[it][pt]); __builtin_amdgcn_sched_barrier(0); } }
        const LAS float* acw = (const LAS float*)(lds + SS_ACUM) + wave * 128; const LAS float* e2w = (const LAS float*)(lds + SS_E2) + wave * 128; const LAS float* eiw = (const LAS float*)(lds + SS_EI) + wave * 128;
#pragma unroll
        for (int it = 0; it < 8; ++it) { const float e = eiw[16 * it + r];
#pragma unroll
            for (int pt = 0; pt < 4; ++pt) acc[it][pt] = acc[it][pt] * e; }
        const float Dh = a.in[I_DSKIP][h];
        for (int jh = 0; jh < 2; ++jh) {
            __syncthreads();
            conv_stage<true, false>(a, XT, SS_XLD, b, c, 512 * g, 128, 64 * jh, 8, nullptr, wave);
            __syncthreads();
#pragma unroll
            for (int kk = 0; kk < 2; ++kk) { const int ks = 2 * jh + kk; const int jb = 32 * ks + 8 * q;
                bf16x8 xf[4];
#pragma unroll
                for (int pt = 0; pt < 4; ++pt) xf[pt] = *(const LAS bf16x8*)(XT + (64 * wave + 16 * (r >> 2) + 4 * pt + (r & 3)) * SS_XLD + (32 * kk + 8 * q) * 2);
                const f32x4 ea = *(const LAS f32x4*)(e2w + jb), eb = *(const LAS f32x4*)(e2w + jb + 4); const float Rk = ((const LAS float*)(lds + SS_R))[wave * 4 + ks];
                const float e2v[8] = {ea[0], ea[1], ea[2], ea[3], eb[0], eb[1], eb[2], eb[3]};
#pragma unroll
                for (int it = 0; it < 8; ++it) { if (16 * it + 15 < 32 * ks) continue;
                    const int i = 16 * it + r; const v4u cbv = *(const LAS v4u*)(CBl + i * SS_LD + jb * 2);
                    float cbf[8]; unpack8(cbv, cbf); const float e1 = __expf(acw[i] - Rk); float mv[8];
                    if (16 * it >= 32 * ks + 32) {
#pragma unroll
                        for (int jj = 0; jj < 8; ++jj) mv[jj] = cbf[jj] * (e1 * e2v[jj]);
                    } else {
#pragma unroll
                        for (int jj = 0; jj < 8; ++jj) { float v = cbf[jj] * (e1 * e2v[jj]); const int j = jb + jj; v = (j <= i) ? v : 0.f; v = (j == i) ? v + Dh : v; mv[jj] = v; } }
                    v4u mw; mw.x = pk2_hw(mv[0], mv[1]); mw.y = pk2_hw(mv[2], mv[3]); mw.z = pk2_hw(mv[4], mv[5]); mw.w = pk2_hw(mv[6], mv[7]);
                    const bf16x8 mf = __builtin_bit_cast(bf16x8, mw);
#pragma unroll
                    for (int pt = 0; pt < 4; ++pt) acc[it][pt] = MFMA16(xf[pt], mf, acc[it][pt]); __builtin_amdgcn_sched_barrier(0); }
            }
        }
        const size_t row0 = (size_t)b * SEQ + (size_t)c * CHK; float ss[8];
        const bf16* zp0 = Z + (row0 + r) * 1024 + 512 * g + 64 * wave + 16 * q;
        v4u zA[4][2], zB[4][2];
#pragma unroll
        for (int it = 0; it < 4; ++it) { zA[it][0] = *(const v4u*)(zp0 + (size_t)(16 * it) * 1024); zA[it][1] = *(const v4u*)(zp0 + (size_t)(16 * it) * 1024 + 8); }
#pragma unroll
        for (int it = 0; it < 4; ++it) { zB[it][0] = *(const v4u*)(zp0 + (size_t)(16 * (it + 4)) * 1024); zB[it][1] = *(const v4u*)(zp0 + (size_t)(16 * (it + 4)) * 1024 + 8); }
#pragma unroll
        for (int it = 0; it < 8; ++it) { ss[it] = 0.f; float zf[16]; unpack8(it < 4 ? zA[it & 3][0] : zB[it & 3][0], zf); unpack8(it < 4 ? zA[it & 3][1] : zB[it & 3][1], zf + 8);
#pragma unroll
            for (int pt = 0; pt < 4; ++pt) { f32x4 v = acc[it][pt];
                v[0] *= zf[4 * pt]; v[1] *= zf[4 * pt + 1]; v[2] *= zf[4 * pt + 2]; v[3] *= zf[4 * pt + 3]; acc[it][pt] = v;     ss[it] += (v[0] * v[0] + v[1] * v[1]) + (v[2] * v[2] + v[3] * v[3]); }
            ss[it] += bperm(ss[it], lane ^ 16); ss[it] += bperm(ss[it], lane ^ 32); __builtin_amdgcn_sched_barrier(0); }
        LAS float* ssum = (LAS float*)(lds + SS_SSUM);
        if (q == 0) {
#pragma unroll
            for (int it = 0; it < 8; ++it) ssum[wave * 128 + 16 * it + r] = ss[it]; }
        __syncthreads();
        const float* nw = a.in[I_SNW] + 512 * g + 64 * wave + 16 * q;
        const f32x4 w0 = *(const f32x4*)nw, w1 = *(const f32x4*)(nw + 4), w2 = *(const f32x4*)(nw + 8), w3 = *(const f32x4*)(nw + 12);
#pragma unroll
        for (int it = 0; it < 8; ++it) { float t = 0.f;
#pragma unroll
            for (int w = 0; w < 8; ++w) t += ssum[w * 128 + 16 * it + r];
            const float rinv = 1.0f / sqrtf(t * (1.f / 512.f) + EPS); bf16* op = g2 + (row0 + 16 * it + r) * G2_LD + 1024 + 512 * g + 64 * wave + 16 * q;
            const f32x4 v0 = acc[it][0] * rinv * w0, v1 = acc[it][1] * rinv * w1, v2 = acc[it][2] * rinv * w2, v3 = acc[it][3] * rinv * w3;
            v4u o0, o1; o0.x = pk2(v0[0], v0[1]); o0.y = pk2(v0[2], v0[3]); o0.z = pk2(v1[0], v1[1]); o0.w = pk2(v1[2], v1[3]);
            o1.x = pk2(v2[0], v2[1]); o1.y = pk2(v2[2], v2[3]); o1.z = pk2(v3[0], v3[1]); o1.w = pk2(v3[2], v3[3]);
            *(v4u*)op = o0; *(v4u*)(op + 8) = o1; }
    }
}
__device__ __forceinline__ void unpack8(const v4u v, float* f) { f[0] = bflo(v.x); f[1] = bfhi(v.x); f[2] = bflo(v.y); f[3] = bfhi(v.y); f[4] = bflo(v.z); f[5] = bfhi(v.z); f[6] = bflo(v.w); f[7] = bfhi(v.w); }
constexpr int SCD = 4;
__device__ __forceinline__ void sc_phase(const Args& a, int gw, int NGW) {
    const int lane = lane_id();
    bf16* g2 = (bf16*)(a.ws + WS_G2); const bf16* pr = (const bf16*)(a.ws + WS_U);
    const int c0 = 16 * lane;
    float w0[16], w1[16], w2[16], nw[16];
#pragma unroll
    for (int j = 0; j < 16; ++j) { w0[j] = a.in[I_SCCW][c0 + j]; w1[j] = a.in[I_SCCW][1024 + c0 + j]; w2[j] = a.in[I_SCCW][2048 + c0 + j]; nw[j] = a.in[I_SCNW][c0 + j]; }
    for (int blk = gw; blk < T / 32; blk += NGW) {
        const int r0 = blk * 32; float p1[16], p2[16];
#pragma unroll
        for (int j = 0; j < 16; ++j) { p1[j] = 0.f; p2[j] = 0.f; }
        if ((r0 % SEQ) != 0) {
            unpack8(*(const v4u*)(pr + (size_t)(r0 - 1) * 1024 + c0), p1); unpack8(*(const v4u*)(pr + (size_t)(r0 - 1) * 1024 + c0 + 8), p1 + 8);
            unpack8(*(const v4u*)(pr + (size_t)(r0 - 2) * 1024 + c0), p2); unpack8(*(const v4u*)(pr + (size_t)(r0 - 2) * 1024 + c0 + 8), p2 + 8);
        }
        v4u nx[SCD][4];
#define SC_LOADROW(q, rowv) { const size_t rl_ = (size_t)(rowv); nx[q][0] = *(const v4u*)(pr + rl_ * 1024 + c0); nx[q][1] = *(const v4u*)(pr + rl_ * 1024 + c0 + 8); \
            nx[q][2] = *(const v4u*)(g2 + rl_ * G2_LD + c0); nx[q][3] = *(const v4u*)(g2 + rl_ * G2_LD + c0 + 8); }
#pragma unroll
        for (int q = 0; q < SCD; ++q) SC_LOADROW(q, r0 + q)
        for (int rr = 0; rr < 32; rr += SCD) {
#pragma unroll
            for (int q = 0; q < SCD; ++q) { const size_t row = (size_t)(r0 + rr + q);
                float pp[16], gb[16], val[16];
                unpack8(nx[q][0], pp); unpack8(nx[q][1], pp + 8); unpack8(nx[q][2], gb); unpack8(nx[q][3], gb + 8);
                { const int rn = r0 + rr + q + SCD; SC_LOADROW(q, rn < r0 + 32 ? rn : r0 + 31) }
                float ss = 0.f;
#pragma unroll
                for (int j = 0; j < 16; ++j) { const float p0 = pp[j]; const float v = w2[j] * p0 + w1[j] * p1[j] + w0[j] * p2[j]; p2[j] = p1[j]; p1[j] = p0; val[j] = gb[j] * v; ss += val[j] * val[j]; }
                const float rinv = 1.0f / sqrtf(wave_sum(ss) * (1.f / 1024.f) + EPS);
                v4u o0, o1;
                o0.x = pk2_hw(val[0] * rinv * nw[0], val[1] * rinv * nw[1]); o0.y = pk2_hw(val[2] * rinv * nw[2], val[3] * rinv * nw[3]); o0.z = pk2_hw(val[4] * rinv * nw[4], val[5] * rinv * nw[5]); o0.w = pk2_hw(val[6] * rinv * nw[6], val[7] * rinv * nw[7]);
                o1.x = pk2_hw(val[8] * rinv * nw[8], val[9] * rinv * nw[9]); o1.y = pk2_hw(val[10] * rinv * nw[10], val[11] * rinv * nw[11]); o1.z = pk2_hw(val[12] * rinv * nw[12], val[13] * rinv * nw[13]); o1.w = pk2_hw(val[14] * rinv * nw[14], val[15] * rinv * nw[15]);
                *(v4u*)(g2 + row * G2_LD + c0) = o0; *(v4u*)(g2 + row * G2_LD + c0 + 8) = o1;
            }
        }
#undef SC_LOADROW
    }
}

__device__ __forceinline__ void p5_slow(const Args& a, LAS unsigned char* lds, int wg, int G) {
    LAS float* As = (LAS float*)lds; LAS float* Bs = As + 32 * SG_LD;
    const bf16* g2 = (const bf16*)(a.ws + WS_G2); const bf16* wt = (const bf16*)(a.ws + WS_WOUT);
    const int t = threadIdx.x, tm = t >> 5, tn = t & 31;
    for (int it = wg; it < (T / 128) * 8; it += G) {
        const int mt = it >> 3, nt = it & 7;
        float acc[8][4];
        auto arow = [&](int r) { return g2 + (size_t)(mt * 128 + r) * 2048; };
        sg_tile(As, Bs, arow, wt + (size_t)nt * 128 * 2048, 2048, 2048, acc);
#pragma unroll
        for (int i = 0; i < 8; ++i) { const size_t off = (size_t)(mt * 128 + 8 * tm + i) * D + nt * 128 + 4 * tn;
            const f32x4 xv = *(const f32x4*)(a.in[I_X] + off);
            *(f32x4*)(a.out + off) = (f32x4){xv.x + acc[i][0], xv.y + acc[i][1], xv.z + acc[i][2], xv.w + acc[i][3]}; }
    }
}

__device__ __forceinline__ void p6_slow(const Args& a, LAS unsigned char* lds, int wg, int G) {
    const int tid = threadIdx.x, lane = tid & 63, wave = tid >> 6;
    LAS unsigned* lcnt = (LAS unsigned*)lds; LAS unsigned* lbase = lcnt + 32; LAS u64* pend = (LAS u64*)(lds + 256);
    const float* h = a.out; const float* nw = a.in[I_N2W]; const float* wr = a.in[I_WR]; const float* br = a.in[I_BR];
    bf16* xn2 = (bf16*)(a.ws + WS_XN2); unsigned* gcount = (unsigned*)(a.ws + WS_CTL) + CW_GCOUNT; u64* ent = (u64*)(a.ws + WS_ENT);
    for (int tb = wg; tb < T / 256; tb += G) {
        __syncthreads();
        if (tid < 32) lcnt[tid] = 0u;
        __syncthreads();
        const int tok0 = tb * 256;
        for (int r = wave; r < 256; r += NWAVES) rms_row_to_bf16(h + (size_t)(tok0 + r) * D, nw, xn2 + (size_t)(tok0 + r) * D, lane);
        const int rl = tid >> 5, e = tid & 31;
        for (int pass = 0; pass < 16; ++pass) {
            const int rloc = pass * 16 + rl, tok = tok0 + rloc; const float* hr = h + (size_t)tok * D;
            float s = 0.f, d = 0.f;
            for (int k = 0; k < D; ++k) { const float hv = hr[k]; s += hv * hv; d += hv * nw[k] * wr[k * NE + e]; }
            const float rinv = 1.0f / sqrtf(s * (1.f / D) + EPS);
            const float v = d * rinv + br[e];
            LAS float* lg = (LAS float*)(lds + 16384);
            __syncthreads();
            lg[rl * 32 + e] = v;
            __syncthreads();
            int rank = 0; float mx = -INFINITY;
#pragma unroll
            for (int e2 = 0; e2 < 32; ++e2) { const float o = lg[rl * 32 + e2]; rank += (o > v || (o == v && e2 < e)) ? 1 : 0; mx = fmaxf(mx, o); }
            const bool sel = rank < 4;
            const float ex = sel ? __expf(v - mx) : 0.f; float sum = ex;
#pragma unroll
            for (int o = 1; o < 32; o <<= 1) sum += __shfl_xor(sum, o);
            if (sel) { const unsigned r = __hip_atomic_fetch_add(&lcnt[e], 1u, __ATOMIC_RELAXED, __HIP_MEMORY_SCOPE_WORKGROUP);
                pend[rloc * 4 + rank] = ((u64)__builtin_bit_cast(unsigned, ex / sum) << 32) | (((unsigned)e << 20) | r); }
        }
        __syncthreads();
        if (tid < 32) lbase[tid] = atomicAdd(&gcount[64 * tid], lcnt[tid]);
        __syncthreads();
        for (int i = tid; i < 1024; i += NTHREADS) { const u64 p = pend[i]; const unsigned px = (unsigned)p, ee = px >> 20, rank = px & 0xfffffu;
            ent[(size_t)ee * ENT_CAP + lbase[ee] + rank] = (p & 0xffffffff00000000ull) | (u64)(unsigned)((tok0 + (i >> 2)) * 4 + (i & 3)); }
    }
}


constexpr int R16_LD = 1028;
template <int NE_>
__device__ __forceinline__ void rows16_stage_w(LAS float* WT, const float* W, int ldw, const float* nw, int wave) {
    for (int i0 = wave * 64 + lane_id(); i0 < 1024 * NE_; i0 += NTHREADS * 8) {
        float v[8];
#pragma unroll
        for (int u = 0; u < 8; ++u) { const int i = i0 + u * NTHREADS, k = i / NE_, e = i % NE_; v[u] = nw[k] * W[(size_t)k * ldw + e]; }
#pragma unroll
        for (int u = 0; u < 8; ++u) { const int i = i0 + u * NTHREADS, k = i / NE_, e = i % NE_; WT[e * R16_LD + k] = v[u]; } }
}
template <int NE_>
__device__ __forceinline__ void rows16_dots(const LAS float* WT, const float* src  , int lane, f32x4 (&acc)[NE_ / 16], float& ssq) {
    const int row = lane & 15, kq = lane >> 4;
    const f32x4* ap = (const f32x4*)(src + (size_t)row * D) + kq;
    const LAS f32x4* bp = (const LAS f32x4*)(WT + row * R16_LD) + kq;
#pragma unroll
    for (int t = 0; t < NE_ / 16; ++t) acc[t] = (f32x4){0.f, 0.f, 0.f, 0.f};
    float s = 0.f;
    f32x4 ca[16], cb[16];
#define R16_LOAD(arr, c) _Pragma("unroll") for (int i_ = 0; i_ < 16; ++i_) arr[i_] = ap[4 * (16 * (c) + i_)];
#define R16_COMP(arr, c) _Pragma("unroll") for (int i_ = 0; i_ < 16; ++i_) { const f32x4 av = arr[i_]; const int sidx = 16 * (c) + i_; \
        s += (av[0] * av[0] + av[1] * av[1]) + (av[2] * av[2] + av[3] * av[3]); \
        _Pragma("unroll") for (int t = 0; t < NE_ / 16; ++t) { const f32x4 bv = bp[(16 * t * R16_LD) / 4 + 4 * sidx]; \
            _Pragma("unroll") for (int j = 0; j < 4; ++j) acc[t] = __builtin_amdgcn_mfma_f32_16x16x4f32(av[j], bv[j], acc[t], 0, 0, 0); } }
    R16_LOAD(ca, 0) R16_LOAD(cb, 1)
    R16_COMP(ca, 0) R16_LOAD(ca, 2)
    R16_COMP(cb, 1) R16_LOAD(cb, 3)
    R16_COMP(ca, 2) R16_COMP(cb, 3)
#undef R16_LOAD
#undef R16_COMP
    s += bperm(s, lane ^ 16); s += bperm(s, lane ^ 32); ssq = s;
}
__device__ __forceinline__ void rows16_norm_store(const float* src, const float* w, bf16* dst, int dst_ld, float rinv_lane, int lane) {
    const f32x4* wr = (const f32x4*)w + lane;
#pragma unroll 4
    for (int i = 0; i < 16; ++i) { const float rinv = bperm(rinv_lane, (lane & 48) | i); const f32x4* xr = (const f32x4*)(src + (size_t)i * D) + lane; v2u* o8 = (v2u*)(dst + (size_t)i * dst_ld) + lane;
#pragma unroll
        for (int j = 0; j < 4; ++j) { const f32x4 v = xr[64 * j], ww = wr[64 * j]; v2u o; o.x = pk2_hw(v[0] * rinv * ww[0], v[1] * rinv * ww[1]); o.y = pk2_hw(v[2] * rinv * ww[2], v[3] * rinv * ww[3]); o8[64 * j] = o; } }
}

__device__ __forceinline__ void rows16_pass_router(const LAS float* WT, const LAS float* wl, const float* src, unsigned char* dst8, int lane, f32x4 (&acc)[2], float& ssq) {
    const int row = lane & 15, kq = lane >> 4;
    const f32x4* ap = (const f32x4*)(src + (size_t)row * D + 16 * kq);
    const LAS f32x4* bp = (const LAS f32x4*)(WT + row * R16_LD + 16 * kq); const LAS f32x4* wp = (const LAS f32x4*)(wl + 16 * kq);
    v4u* op = (v4u*)(dst8 + (size_t)row * D + 16 * kq);
    acc[0] = (f32x4){0.f, 0.f, 0.f, 0.f}; acc[1] = (f32x4){0.f, 0.f, 0.f, 0.f}; float s = 0.f;
    f32x4 ca[8], cb[8], cc[8];
#define RR_LOAD(arr, c) { _Pragma("unroll") for (int i_ = 0; i_ < 8; ++i_) arr[i_] = ap[16 * (2 * (c) + (i_ >> 2)) + (i_ & 3)]; __builtin_amdgcn_sched_barrier(0); }
#define RR_COMP(arr, c) _Pragma("unroll") for (int ss_ = 0; ss_ < 2; ++ss_) { const int S = 2 * (c) + ss_; v4u o_; \
        _Pragma("unroll") for (int jp = 0; jp < 4; ++jp) { const f32x4 x = arr[4 * ss_ + jp]; s += (x[0] * x[0] + x[1] * x[1]) + (x[2] * x[2] + x[3] * x[3]); \
            { const f32x4 bv0 = bp[16 * S + jp], bv1 = bp[(16 * R16_LD) / 4 + 16 * S + jp];     \
                _Pragma("unroll") for (int j = 0; j < 4; ++j) { acc[0] = __builtin_amdgcn_mfma_f32_16x16x4f32(x[j], bv0[j], acc[0], 0, 0, 0); acc[1] = __builtin_amdgcn_mfma_f32_16x16x4f32(x[j], bv1[j], acc[1], 0, 0, 0); } } \
            const f32x4 p = x * wp[16 * S + jp]; o_[jp] = pk4_fp8(p[0], p[1], p[2], p[3]); } \
        op[4 * S] = o_; }
    RR_LOAD(ca, 0) RR_LOAD(cb, 1) RR_LOAD(cc, 2)
    RR_COMP(ca, 0) RR_LOAD(ca, 3)
    RR_COMP(cb, 1) RR_LOAD(cb, 4)
    RR_COMP(cc, 2) RR_LOAD(cc, 5)
    RR_COMP(ca, 3) RR_LOAD(ca, 6)
    RR_COMP(cb, 4) RR_LOAD(cb, 7)
    RR_COMP(cc, 5) RR_COMP(ca, 6) RR_COMP(cb, 7)
#undef RR_LOAD
#undef RR_COMP
    s += bperm(s, lane ^ 16); s += bperm(s, lane ^ 32); ssq = s;
}
__device__ __forceinline__ void rows16_norm_store8(const float* src, const float* w, unsigned char* dst, float rinv_lane, int lane) {
    const f32x4* wr = (const f32x4*)w + lane;
#pragma unroll 4
    for (int i = 0; i < 16; ++i) { const float rinv = bperm(rinv_lane, (lane & 48) | i); const f32x4* xr = (const f32x4*)(src + (size_t)i * D) + lane; unsigned* o4 = (unsigned*)(dst + (size_t)i * D) + lane;
#pragma unroll
        for (int j = 0; j < 4; ++j) { const f32x4 v = xr[64 * j], ww = wr[64 * j]; o4[64 * j] = pk4_fp8(v[0] * rinv * ww[0], v[1] * rinv * ww[1], v[2] * rinv * ww[2], v[3] * rinv * ww[3]); } }
}
__device__ __forceinline__ void rows16_pass1(const LAS float* WT, const float* src, const LAS float* w, bf16* dst, int dst_ld, int lane, f32x4& acc, float& ssq) {
    const int row = lane & 15, kq = lane >> 4;
    const f32x4* ap = (const f32x4*)(src + (size_t)row * D + 16 * kq); const LAS f32x4* wp = (const LAS f32x4*)(w + 16 * kq);
    const LAS f32x4* bp = (const LAS f32x4*)(WT + row * R16_LD + 16 * kq);
    v4u* op = (v4u*)(dst + (size_t)row * dst_ld + 16 * kq);
    acc = (f32x4){0.f, 0.f, 0.f, 0.f}; float s = 0.f;
#pragma unroll 1
    for (int S2 = 0; S2 < 16; S2 += 4) {
        f32x4 av[4][4];
#pragma unroll
        for (int hs = 0; hs < 4; ++hs)
#pragma unroll
            for (int jp = 0; jp < 4; ++jp) av[hs][jp] = ap[16 * (S2 + hs) + jp];
        __builtin_amdgcn_sched_barrier(0);
#pragma unroll
        for (int hs = 0; hs < 4; ++hs) { const int S = S2 + hs; f32x4 pr[4];
#pragma unroll
            for (int jp = 0; jp < 4; ++jp) { const f32x4 x = av[hs][jp]; const f32x4 bv = bp[16 * S + jp]; s += (x[0] * x[0] + x[1] * x[1]) + (x[2] * x[2] + x[3] * x[3]);
#pragma unroll
                for (int j = 0; j < 4; ++j) acc = __builtin_amdgcn_mfma_f32_16x16x4f32(x[j], bv[j], acc, 0, 0, 0);
                pr[jp] = x * wp[16 * S + jp]; }
            v4u o0, o1;
            o0.x = pk2_hw(pr[0][0], pr[0][1]); o0.y = pk2_hw(pr[0][2], pr[0][3]); o0.z = pk2_hw(pr[1][0], pr[1][1]); o0.w = pk2_hw(pr[1][2], pr[1][3]);
            o1.x = pk2_hw(pr[2][0], pr[2][1]); o1.y = pk2_hw(pr[2][2], pr[2][3]); o1.z = pk2_hw(pr[3][0], pr[3][1]); o1.w = pk2_hw(pr[3][2], pr[3][3]);
            op[8 * S] = o0; op[8 * S + 1] = o1; }
    }
    s += bperm(s, lane ^ 16); s += bperm(s, lane ^ 32); ssq = s;
}
__device__ __forceinline__ void p0_rows_fast(const Args& a, LAS unsigned char* lds, int gw, int NGW, int wave) {
    LAS float* WT = (LAS float*)lds;
    __syncthreads();
    rows16_stage_w<16>(WT, a.in[I_WIN] + DT_COL0, PROJ_DIM, a.in[I_N1W], wave);
    LAS float* wl = (LAS float*)(lds + 66048);
    { const int tid = wave * 64 + lane_id(); wl[tid] = a.in[I_N1W][tid]; wl[tid + 512] = a.in[I_N1W][tid + 512]; }
    __syncthreads();
    float* dt = (float*)(a.ws + WS_DT); bf16* xn = (bf16*)((unsigned char*)a.out + DO_XN); float* rinvt = (float*)(a.ws + WS_RINV);
    for (int grp = gw; grp < T / 16; grp += NGW) {
        const int lane = lane_id_v();
        const float* src = a.in[I_X] + (size_t)grp * 16 * D;
        f32x4 acc; float ssq; rows16_pass1(WT, src, wl, xn + (size_t)grp * 16 * XN_LD, XN_LD, lane, acc, ssq);
        const float rinv = 1.0f / sqrtf(ssq * (1.f / D) + EPS);
        if (lane < 16) rinvt[(size_t)grp * 16 + lane] = rinv;
#pragma unroll
        for (int reg = 0; reg < 4; ++reg) { const int rr = 4 * (lane >> 4) + reg; const float ri = bperm(rinv, (lane & 48) | rr); dt[((size_t)grp * 16 + rr) * 16 + (lane & 15)] = softplus_f(acc[reg] * ri + a.in[I_DTB][lane & 15]); }
    }
}
__device__ __forceinline__ void p6_fast(const Args& a, LAS unsigned char* lds, int wg, int G, int wave) {
    LAS float* WT = (LAS float*)lds; LAS float* lg = (LAS float*)(lds + 131584) + wave * 512;
    LAS unsigned* lcnt = (LAS unsigned*)(lds + 147968); LAS unsigned* lbase = lcnt + 32; LAS u64* pend = (LAS u64*)(lds + 148224);
    LAS float* rinv_l = (LAS float*)(lds + 156416); LAS float* wl = (LAS float*)(lds + 157440);
    float* erinv = (float*)(a.ws + WS_ERINV);
    const float* h = a.out; bf16* xn2 = (bf16*)(a.ws + WS_XN2); unsigned* gcount = (unsigned*)(a.ws + WS_CTL) + CW_GCOUNT; u64* ent = (u64*)(a.ws + WS_ENT);
    __syncthreads();
    rows16_stage_w<32>(WT, a.in[I_WR], NE, a.in[I_N2W], wave);
    { const int tid = wave * 64 + lane_id(); wl[tid] = a.in[I_N2W][tid]; wl[tid + 512] = a.in[I_N2W][tid + 512]; }
    for (int tb = wg; tb < T / 256; tb += G) {
        __syncthreads();
        { const int tid = wave * 64 + lane_id(); if (tid < 32) lcnt[tid] = 0u; }
        __syncthreads();
        const int tok0 = tb * 256;
        for (int gi = 0; gi < 2; ++gi) {
            const int lane = lane_id_v();
            const int rbase = (wave * 2 + gi) * 16; const float* src = h + (size_t)(tok0 + rbase) * D;
            f32x4 acc[2]; float ssq; rows16_pass_router(WT, wl, src, (unsigned char*)xn2 + (size_t)(tok0 + rbase) * D, lane, acc, ssq);
            const float rinv = 1.0f / sqrtf(ssq * (1.f / D) + EPS);
            if (lane < 16) rinv_l[rbase + lane] = rinv;
            const int c = lane & 15, q = lane >> 4; const float b0 = a.in[I_BR][c], b1 = a.in[I_BR][16 + c];
#pragma unroll
            for (int reg = 0; reg < 4; ++reg) { const int rr = 4 * q + reg; const float ri = bperm(rinv, (lane & 48) | rr); lg[rr * 32 + c] = acc[0][reg] * ri + b0; lg[rr * 32 + 16 + c] = acc[1][reg] * ri + b1; }
            LDS_WAIT(); asm volatile("" ::: "memory");
            { const int tl = lane >> 2, part = lane & 3; float mine[8]; int rk[8];
              { const f32x4 m0 = *(const LAS f32x4*)(lg + tl * 32 + 8 * part), m1 = *(const LAS f32x4*)(lg + tl * 32 + 8 * part + 4);
                mine[0] = m0[0]; mine[1] = m0[1]; mine[2] = m0[2]; mine[3] = m0[3]; mine[4] = m1[0]; mine[5] = m1[1]; mine[6] = m1[2]; mine[7] = m1[3]; }
              unsigned km[8];
#pragma unroll
              for (int m = 0; m < 8; ++m) { rk[m] = 0; unsigned bb = __builtin_bit_cast(unsigned, mine[m]); bb ^= ((unsigned)((int)bb >> 31) | 0x80000000u); km[m] = (bb & ~31u) | (unsigned)(31 - (8 * part + m)); }
              float mx = -INFINITY;
#pragma unroll
              for (int j4 = 0; j4 < 8; ++j4) { const f32x4 v = *(const LAS f32x4*)(lg + tl * 32 + 4 * j4);
#pragma unroll
                  for (int jj = 0; jj < 4; ++jj) { const float o = v[jj]; mx = fmaxf(mx, o); unsigned bb = __builtin_bit_cast(unsigned, o); bb ^= ((unsigned)((int)bb >> 31) | 0x80000000u); const unsigned ko = (bb & ~31u) | (unsigned)(31 - (4 * j4 + jj));
#pragma unroll
                      for (int m = 0; m < 8; ++m) rk[m] += (ko > km[m]) ? 1 : 0; } }
              float exs = 0.f;
#pragma unroll
              for (int m = 0; m < 8; ++m) if (rk[m] < 4) exs += __expf(mine[m] - mx);
              exs += bperm(exs, lane ^ 1); exs += bperm(exs, lane ^ 2);
              const float inv = 1.0f / exs;
#pragma unroll
              for (int m = 0; m < 8; ++m) if (rk[m] < 4) { const int e = 8 * part + m; const unsigned rnk = __hip_atomic_fetch_add(&lcnt[e], 1u, __ATOMIC_RELAXED, __HIP_MEMORY_SCOPE_WORKGROUP);
                  pend[(rbase + tl) * 4 + rk[m]] = ((u64)__builtin_bit_cast(unsigned, __expf(mine[m] - mx) * inv) << 32) | (((unsigned)e << 20) | rnk); }
            }
            LDS_WAIT(); asm volatile("" ::: "memory");
        }
        __syncthreads();
        const int tid = wave * 64 + lane_id();
        if (tid < 32) lbase[tid] = atomicAdd(&gcount[64 * tid], lcnt[tid]);
        __syncthreads();
        for (int i = tid; i < 1024; i += NTHREADS) { const u64 p = pend[i]; const unsigned px = (unsigned)p, ee = px >> 20, rank = px & 0xfffffu;
            const size_t ei = (size_t)ee * ENT_CAP + lbase[ee] + rank;
            ent[ei] = (p & 0xffffffff00000000ull) | (u64)(unsigned)((tok0 + (i >> 2)) * 4 + (i & 3)); erinv[ei] = rinv_l[i >> 2]; }
    }
}
__device__ __forceinline__ void moe_tables(const Args& a, LAS unsigned* tab, int wave = -1) {
    const unsigned* gcount = (const unsigned*)(a.ws + WS_CTL) + CW_GCOUNT; const int tidx = wave < 0 ? (int)threadIdx.x : wave * 64 + lane_id();
    __syncthreads();
    if (tidx < 32) tab[tidx] = __hip_atomic_load(gcount + 64 * tidx, __ATOMIC_RELAXED, __HIP_MEMORY_SCOPE_AGENT);
    __syncthreads();
    if (tidx == 0) { unsigned p = 0; for (int e = 0; e < 32; ++e) { tab[32 + e] = p; p += (tab[e] + 255u) >> 8; } tab[64] = p; }
    __syncthreads();
}
__device__ __forceinline__ int moe_find_e(const LAS unsigned* tab, int gp) { int e = 0;
#pragma unroll
    for (int s = 16; s >= 1; s >>= 1) if (tab[32 + e + s] <= (unsigned)gp) e += s;
    return e; }
__device__ __forceinline__ float swiglu_f(float g, float u) { g = fminf(g, SWI_LIMIT); u = fminf(fmaxf(u, -SWI_LIMIT), SWI_LIMIT); return (u + 1.0f) * (g / (1.0f + __expf(-SWI_ALPHA * g))); }

__device__ __forceinline__ void p7_slow(const Args& a, LAS unsigned char* lds, int wg, int G) {
    LAS unsigned* tab = (LAS unsigned*)(lds + 40960); moe_tables(a, tab);
    LAS float* As = (LAS float*)lds; LAS float* Bs = As + 32 * SG_LD;
    const bf16* xn2 = (const bf16*)(a.ws + WS_XN2); const bf16* wgu = (const bf16*)(a.ws + WS_WGU); const u64* ent = (const u64*)(a.ws + WS_ENT);
    bf16* hid = (bf16*)(a.ws + WS_HID);
    const int t = threadIdx.x, tm = t >> 5, tn = t & 31, NP = (int)tab[64];
    for (int it = wg; it < NP * 16; it += G) {
        const int gp = it >> 4, half = (it >> 3) & 1, jt = it & 7, e = moe_find_e(tab, gp), pl = gp - (int)tab[32 + e], cnt = (int)tab[e];
        auto arow = [&](int r) { int pos = pl * 256 + half * 128 + r; pos = pos < cnt ? pos : cnt - 1; const unsigned tok = (unsigned)ent[(size_t)e * ENT_CAP + pos] >> 2; return xn2 + (size_t)tok * D; };
        float ag[8][4], au[8][4];
        const bf16* wb = wgu + (size_t)e * 2048 * D + (size_t)(256 * jt) * D;
        sg_tile(As, Bs, arow, wb, D, D, ag);
        sg_tile(As, Bs, arow, wb + (size_t)128 * D, D, D, au);
        const int j0 = 128 * jt + 4 * tn; const float* bg = a.in[I_BGU] + (size_t)e * 2048 + j0; const float* bu = bg + 1024;
#pragma unroll
        for (int i = 0; i < 8; ++i) { const size_t row = (size_t)gp * 256 + half * 128 + 8 * tm + i;
            v2u o; o.x = pk2(swiglu_f(ag[i][0] + bg[0], au[i][0] + bu[0]), swiglu_f(ag[i][1] + bg[1], au[i][1] + bu[1]));
            o.y = pk2(swiglu_f(ag[i][2] + bg[2], au[i][2] + bu[2]), swiglu_f(ag[i][3] + bg[3], au[i][3] + bu[3]));
            *(v2u*)(hid + row * FF + j0) = o; }
    }
}
__device__ __forceinline__ bf16* slot_ptr(unsigned char* ws, int k) { return (bf16*)(ws + (k == 0 ? WS_SLOT0 : (k == 1 ? WS_SLOT1 : (k == 2 ? WS_SLOT2 : WS_SLOT3)))); }
__device__ __forceinline__ void p8_slow(const Args& a, LAS unsigned char* lds, int wg, int G) {
    LAS unsigned* tab = (LAS unsigned*)(lds + 40960); moe_tables(a, tab);
    LAS float* As = (LAS float*)lds; LAS float* Bs = As + 32 * SG_LD;
    const bf16* hid = (const bf16*)(a.ws + WS_HID); const bf16* wd = (const bf16*)(a.ws + WS_WD); const u64* ent = (const u64*)(a.ws + WS_ENT);
    const int t = threadIdx.x, tm = t >> 5, tn = t & 31, NP = (int)tab[64];
    for (int it = wg; it < NP * 16; it += G) {
        const int gp = it >> 4, half = (it >> 3) & 1, nt = it & 7, e = moe_find_e(tab, gp), pl = gp - (int)tab[32 + e], cnt = (int)tab[e];
        auto arow = [&](int r) { return hid + ((size_t)gp * 256 + half * 128 + r) * FF; };
        float acc[8][4];
        sg_tile(As, Bs, arow, wd + (size_t)e * D * FF + (size_t)(128 * nt) * FF, FF, FF, acc);
        const int c0 = 128 * nt + 4 * tn; const float* bd = a.in[I_BD] + (size_t)e * D + c0;
#pragma unroll
        for (int i = 0; i < 8; ++i) { const int pos = pl * 256 + half * 128 + 8 * tm + i; if (pos >= cnt) continue;
            const u64 en = ent[(size_t)e * ENT_CAP + pos]; const unsigned enx = (unsigned)en; const float gt = __builtin_bit_cast(float, (unsigned)(en >> 32)); const int k = enx & 3; const size_t tok = enx >> 2;
            const float v0 = (acc[i][0] + bd[0]) * gt, v1 = (acc[i][1] + bd[1]) * gt, v2 = (acc[i][2] + bd[2]) * gt, v3 = (acc[i][3] + bd[3]) * gt;
            if (k == 0) { f32x4* p = (f32x4*)(a.out + tok * D + c0); const f32x4 o = *p; *p = (f32x4){o.x + v0, o.y + v1, o.z + v2, o.w + v3}; }
            else { v2u o; o.x = pk2(v0, v1); o.y = pk2(v2, v3); *(v2u*)(slot_ptr(a.ws, k) + tok * D + c0) = o; } }
    }
}

constexpr int EBUF_OFF = 131072 + 4096;
constexpr int TAB_OFF = 131072;
struct EpiProj {
    static constexpr bool PERM = true; static constexpr int NST = 8; unsigned char* ws;
    __device__ __forceinline__ void dma(const pg8::Unit& u, LAS unsigned char* eb, int wid, int lane) const {
        if (wid == 0) __builtin_amdgcn_global_load_lds((const unsigned*)((const float*)(ws + WS_RINV) + u.pm * 256 + 4 * lane), (LAS unsigned*)eb, 16, 0, 0);
    }
    __device__ __forceinline__ void operator()(const f32x4 (&acc)[2][2][4][2], const pg8::Unit& u, int wr, int wc, int fr, int fq, const LAS unsigned char* eb) const {
        const LAS float* rinvt = (const LAS float*)eb + wr * 64 + fr; float ri[2][4];
#pragma unroll
        for (int ai = 0; ai < 2; ++ai)
#pragma unroll
            for (int m = 0; m < 4; ++m) ri[ai][m] = rinvt[ai * 128 + m * 16];
        const int pn = u.pn; bf16* base; int ldc, colt;
        if (pn < 4) { base = (bf16*)(ws + WS_Z); ldc = 1024; colt = 256 * pn; } else if (pn < 10) { base = (bf16*)(ws + WS_XBC); ldc = DXBC; colt = 256 * (pn - 4); }
        else { base = (bf16*)(ws + WS_G2); ldc = G2_LD; colt = 256 * (pn - 10); }
        const int row0 = u.pm * 256 + wr * 64 + fr, col0 = colt + wc * 32 + 8 * fq;
        if (pn >= 14) {
            bf16* pb = (bf16*)(ws + WS_U) + (size_t)row0 * 1024 + 128 * (pn - 14) + wc * 32 + 8 * fq;
#pragma unroll
            for (int ai = 0; ai < 2; ++ai)
#pragma unroll
                for (int m = 0; m < 4; ++m) { const float r2 = ri[ai][m] * ri[ai][m];
                    const f32x4 v0 = acc[ai][0][m][0] * acc[ai][1][m][0] * r2, v1 = acc[ai][0][m][1] * acc[ai][1][m][1] * r2;
                    v4u w; w.x = pg8::cvt_pk_bf16(v0[0], v0[1]); w.y = pg8::cvt_pk_bf16(v0[2], v0[3]); w.z = pg8::cvt_pk_bf16(v1[0], v1[1]); w.w = pg8::cvt_pk_bf16(v1[2], v1[3]);
                    *(v4u*)(pb + (size_t)(ai * 128 + m * 16) * 1024) = w; }
            return; }
#pragma unroll
        for (int ai = 0; ai < 2; ++ai)
#pragma unroll
            for (int m = 0; m < 4; ++m) { bf16* rowp = base + (size_t)(row0 + ai * 128 + m * 16) * ldc + col0;
#pragma unroll
                for (int bj = 0; bj < 2; ++bj) { f32x4 v0 = acc[ai][bj][m][0] * ri[ai][m], v1 = acc[ai][bj][m][1] * ri[ai][m];
                    if (pn < 4) {
#pragma unroll
                        for (int j = 0; j < 4; ++j) { v0[j] = silu_fast(v0[j]); v1[j] = silu_fast(v1[j]); } }
                    v4u w; w.x = pg8::cvt_pk_bf16(v0[0], v0[1]); w.y = pg8::cvt_pk_bf16(v0[2], v0[3]); w.z = pg8::cvt_pk_bf16(v1[0], v1[1]); w.w = pg8::cvt_pk_bf16(v1[2], v1[3]);
                    *(v4u*)(rowp + bj * 128) = w; } }
    }
};
struct EpiResid {
    static constexpr bool PERM = false; static constexpr int NST = 32; const float* x; float* out;
    __device__ __forceinline__ void dma(const pg8::Unit&, LAS unsigned char*, int, int) const {}
    __device__ __forceinline__ void operator()(const f32x4 (&acc)[2][2][4][2], const pg8::Unit& u, int wr, int wc, int fr, int fq, const LAS unsigned char*) const {
        const int row0 = u.pm * 256 + wr * 64 + fr, col0 = u.pn * 256 + wc * 32 + 4 * fq;
#pragma unroll
        for (int ai = 0; ai < 2; ++ai)
#pragma unroll
            for (int m = 0; m < 4; ++m) { const size_t off = (size_t)(row0 + ai * 128 + m * 16) * D + col0;
#pragma unroll
                for (int bj = 0; bj < 2; ++bj)
#pragma unroll
                    for (int n = 0; n < 2; ++n) { const f32x4 xv = *(const f32x4*)(x + off + bj * 128 + n * 16); *(f32x4*)(out + off + bj * 128 + n * 16) = xv + acc[ai][bj][m][n]; } }
    }
};

constexpr float W8_SCALE = 32.0f, W8_INV = 1.0f / 32.0f;
__device__ __forceinline__ float clamp448(float v) { return __builtin_amdgcn_fmed3f(v, -448.f, 448.f); }
__device__ __forceinline__ unsigned pk4_fp8(float a, float b, float c, float d) { unsigned w = 0; w = __builtin_amdgcn_cvt_pk_fp8_f32(clamp448(a), clamp448(b), w, false); w = __builtin_amdgcn_cvt_pk_fp8_f32(clamp448(c), clamp448(d), w, true); return w; }
__device__ __forceinline__ unsigned pk4_fp8_nc(float a, float b, float c, float d) { unsigned w = 0; w = __builtin_amdgcn_cvt_pk_fp8_f32(a, b, w, false); w = __builtin_amdgcn_cvt_pk_fp8_f32(c, d, w, true); return w; }
__device__ __forceinline__ float swiglu_fast(float g, float u1) { g = fminf(g, SWI_LIMIT); u1 = __builtin_amdgcn_fmed3f(u1, 1.0f - SWI_LIMIT, 1.0f + SWI_LIMIT);
    return u1 * g * __builtin_amdgcn_rcpf(1.0f + __builtin_amdgcn_exp2f(g * (-SWI_ALPHA * 1.44269504f))); }
struct EpiSwiglu {
    static constexpr bool PERM = true; static constexpr int NST = 8; const float* bgu; unsigned char* hid; const float* erinv; const LAS unsigned* tab;
    __device__ __forceinline__ void dma(const pg8::Unit& u, LAS unsigned char* eb, int wid, int lane) const {
        const int e = u.aux;
        if (wid == 0) __builtin_amdgcn_global_load_lds((const unsigned*)(bgu + (size_t)e * 2048 + (lane >> 5) * 1024 + 128 * u.pn + 4 * (lane & 31)), (LAS unsigned*)eb, 16, 0, 0);
        if (wid == 1) { const int pl = u.pm - (int)tab[32 + e]; __builtin_amdgcn_global_load_lds((const unsigned*)(erinv + (size_t)e * ENT_CAP + pl * 256 + 4 * lane), (LAS unsigned*)(eb + 1024), 16, 0, 0); }
    }
    __device__ __forceinline__ void operator()(const f32x4 (&acc)[2][2][4][2], const pg8::Unit& u, int wr, int wc, int fr, int fq, const LAS unsigned char* eb) const {
        const int j0 = 128 * u.pn + wc * 32 + 8 * fq; const LAS float* bg = (const LAS float*)eb + wc * 32 + 8 * fq;
        const f32x4 g0 = *(const LAS f32x4*)bg, g1 = *(const LAS f32x4*)(bg + 4), u0 = *(const LAS f32x4*)(bg + 128) + 1.0f, u1 = *(const LAS f32x4*)(bg + 132) + 1.0f;
        const LAS float* erp = (const LAS float*)(eb + 1024) + wr * 64 + fr; float rs[2][4];
#pragma unroll
        for (int ai = 0; ai < 2; ++ai)
#pragma unroll
            for (int m = 0; m < 4; ++m) rs[ai][m] = erp[ai * 128 + m * 16];
#pragma unroll
        for (int ai = 0; ai < 2; ++ai) {
#pragma unroll
            for (int m = 0; m < 4; ++m) { const size_t row = (size_t)u.pm * 256 + ai * 128 + wr * 64 + m * 16 + fr;
                const float rsc = rs[ai][m] * W8_INV; const f32x4 a0 = acc[ai][0][m][0] * rsc + g0, a1 = acc[ai][0][m][1] * rsc + g1, b0 = acc[ai][1][m][0] * rsc + u0, b1 = acc[ai][1][m][1] * rsc + u1;
                v2u w; w.x = pk4_fp8_nc(swiglu_fast(a0[0], b0[0]), swiglu_fast(a0[1], b0[1]), swiglu_fast(a0[2], b0[2]), swiglu_fast(a0[3], b0[3]));
                w.y = pk4_fp8_nc(swiglu_fast(a1[0], b1[0]), swiglu_fast(a1[1], b1[1]), swiglu_fast(a1[2], b1[2]), swiglu_fast(a1[3], b1[3]));
                *(v2u*)(hid + row * FF + j0) = w; } }
    }
};
struct EpiDown {
    static constexpr bool PERM = true; static constexpr int NST = 0; const float* bd; const u64* ent; const LAS unsigned* tab; float* out; unsigned char* ws;
    __device__ __forceinline__ void dma(const pg8::Unit& u, LAS unsigned char* eb, int wid, int lane) const {
        const int e = u.aux;
        if (wid == 0) __builtin_amdgcn_global_load_lds((const unsigned*)(bd + (size_t)e * D + 256 * u.pn + 4 * lane), (LAS unsigned*)eb, 16, 0, 0);
        if (wid == 1 || wid == 2) { const int pl = u.pm - (int)tab[32 + e];
            __builtin_amdgcn_global_load_lds((const unsigned*)(ent + (size_t)e * ENT_CAP + pl * 256 + 128 * (wid - 1) + 2 * lane), (LAS unsigned*)(eb + 1024 + 1024 * (wid - 1)), 16, 0, 0); }
    }
    __device__ __forceinline__ void operator()(const f32x4 (&acc)[2][2][4][2], const pg8::Unit& u, int wr, int wc, int fr, int fq, const LAS unsigned char* eb) const {
        const int e = u.aux, pl = u.pm - (int)tab[32 + e], cnt = (int)tab[e], c0 = 256 * u.pn + wc * 32 + 8 * fq; const LAS float* bp = (const LAS float*)eb + wc * 32 + 8 * fq;
        f32x4 bv[2][2];
#pragma unroll
        for (int bj = 0; bj < 2; ++bj) { bv[bj][0] = *(const LAS f32x4*)(bp + bj * 128); bv[bj][1] = *(const LAS f32x4*)(bp + bj * 128 + 4); }
        const LAS u64* enp = (const LAS u64*)(eb + 1024) + wr * 64 + fr; u64 en8[2][4];
#pragma unroll
        for (int ai = 0; ai < 2; ++ai)
#pragma unroll
            for (int m = 0; m < 4; ++m) en8[ai][m] = enp[ai * 128 + m * 16];
#pragma unroll
        for (int ai = 0; ai < 2; ++ai)
#pragma unroll
            for (int m = 0; m < 4; ++m) { const int pos = pl * 256 + ai * 128 + wr * 64 + m * 16 + fr; if (pos >= cnt) continue;
                const u64 en = en8[ai][m]; const unsigned enx = (unsigned)en; const float gt = __builtin_bit_cast(float, (unsigned)(en >> 32)); const int k = enx & 3; const size_t tok = enx >> 2;
                bf16* dst = slot_ptr(ws, k) + tok * D + c0;
#pragma unroll
                for (int bj = 0; bj < 2; ++bj) { const f32x4 v0 = (acc[ai][bj][m][0] * W8_INV + bv[bj][0]) * gt, v1 = (acc[ai][bj][m][1] * W8_INV + bv[bj][1]) * gt;
                    v4u w; w.x = pg8::cvt_pk_bf16(v0[0], v0[1]); w.y = pg8::cvt_pk_bf16(v0[2], v0[3]); w.z = pg8::cvt_pk_bf16(v1[0], v1[1]); w.w = pg8::cvt_pk_bf16(v1[2], v1[3]);
                    *(v4u*)(dst + bj * 128) = w; } }
    }
};
struct MoeSched {
    const LAS unsigned* tab; int NP, npn, G, vc; const u64* ent; const char* Bt; size_t estepB, tstepB; bool gather; unsigned rowB, ldbB;
    __device__ __forceinline__ void init(const LAS unsigned* tab_, int npn_, int G_, int c, const u64* ent_, const void* Bt_, size_t estepB_, size_t tstepB_, bool gather_, unsigned rowB_) { rowB = rowB_; ldbB = rowB_;
        tab = tab_; NP = (int)tab_[64]; npn = npn_; G = G_; vc = (G_ % 8 == 0) ? (c & 7) * (G_ / 8) + (c >> 3) : c; ent = ent_; Bt = (const char*)Bt_; estepB = estepB_; tstepB = tstepB_; gather = gather_; }
    bool rev = false;
    __device__ __forceinline__ bool next(int i, pg8::Unit& u) const { int ug = i * G + vc; if (ug >= NP * npn) return false; if (rev) ug = NP * npn - 1 - ug; u.pm = ug / npn; u.pn = ug % npn; u.aux = moe_find_e(tab, u.pm); return true; }
    __device__ __forceinline__ void a_offs(const pg8::Unit& u, int tid, unsigned (&o0)[2], unsigned (&o1)[2]) const {
        int R[2], C[2]; pg8::stage_rc(tid * 16, R[0], C[0]); pg8::stage_rc(tid * 16 + 8192, R[1], C[1]);
        if (gather) { const int e = u.aux, pl = u.pm - (int)tab[32 + e], cnt = (int)tab[e];
#pragma unroll
            for (int i = 0; i < 2; ++i) { int p0 = pl * 256 + R[i], p1 = p0 + 128; p0 = p0 < cnt ? p0 : cnt - 1; p1 = p1 < cnt ? p1 : cnt - 1;
                const unsigned t0 = (unsigned)ent[(size_t)e * ENT_CAP + p0] >> 2, t1 = (unsigned)ent[(size_t)e * ENT_CAP + p1] >> 2;
                o0[i] = t0 * rowB + (unsigned)C[i] * 2u; o1[i] = t1 * rowB + (unsigned)C[i] * 2u; } }
        else {
#pragma unroll
            for (int i = 0; i < 2; ++i) { o0[i] = (unsigned)(u.pm * 256 + R[i]) * rowB + (unsigned)C[i] * 2u; o1[i] = o0[i] + 128u * rowB; } }
    }
    __device__ __forceinline__ const char* b_base(const pg8::Unit& u) const { return Bt + (size_t)u.aux * estepB + (size_t)u.pn * tstepB; }
};
__device__ __forceinline__ void p1_fast(const Args& a, LAS unsigned char* lds, int wg, int G, int wave) {
    pg8::DenseSched S; S.init(T, NPROJ, G, wg, XN_LD); S.GS = 4; S.Bt = (const char*)(a.ws + WS_WIN); S.tstepB = (size_t)256 * WIN_LD * 2; S.ldbB = WIN_LD * 2;
    EpiProj E{a.ws};
    pg8::gemm_phase<EpiProj, pg8::DenseSched, true>(lds, (const char*)a.out + DO_XN, D, S, E, wave);
}
__device__ __forceinline__ void p5_fast(const Args& a, LAS unsigned char* lds, int wg, int G, int wave) {
    pg8::DenseSched S; S.init(T, D, G, wg, G2_LD); S.rev = true; S.Bt = (const char*)(a.ws + WS_WOUT); S.tstepB = (size_t)256 * WOUT_LD * 2; S.ldbB = WOUT_LD * 2;
    EpiResid E{a.in[I_X], a.out};
    pg8::gemm_phase<EpiResid, pg8::DenseSched, true>(lds, (const char*)(a.ws + WS_G2), 2048, S, E, wave);
}
__device__ __forceinline__ void p7_fast(const Args& a, LAS unsigned char* lds, int wg, int G, int wave) {
    LAS unsigned* tab = (LAS unsigned*)(lds + TAB_OFF); moe_tables(a, tab, wave);
    MoeSched S; S.init(tab, 8, G, wg, (const u64*)(a.ws + WS_ENT), a.ws + WS_WGU, (size_t)2048 * D, (size_t)256 * D, true, (unsigned)D);
    EpiSwiglu E{a.in[I_BGU], a.ws + WS_HID, (const float*)(a.ws + WS_ERINV), tab};
    pg8::gemm_phase<EpiSwiglu, MoeSched, true, true>(lds, (const char*)(a.ws + WS_XN2), D / 2, S, E, wave);
}
__device__ __forceinline__ void p8_fast(const Args& a, LAS unsigned char* lds, int wg, int G, int wave) {
    LAS unsigned* tab = (LAS unsigned*)(lds + TAB_OFF); moe_tables(a, tab, wave);
    MoeSched S; S.init(tab, 4, G, wg, (const u64*)(a.ws + WS_ENT), a.ws + WS_WD, (size_t)D * FF, (size_t)256 * FF, false, (unsigned)FF); S.rev = true;
    EpiDown E{a.in[I_BD], (const u64*)(a.ws + WS_ENT), tab, a.out, a.ws};
    pg8::gemm_phase<EpiDown, MoeSched, true, true>(lds, (const char*)(a.ws + WS_HID), FF / 2, S, E, wave);
}
__device__ __forceinline__ void p9_final(const Args& a, int gw, int NGW) {
    const int lane = lane_id();
    const bf16* s0 = (const bf16*)(a.ws + WS_SLOT0); const bf16* s1 = (const bf16*)(a.ws + WS_SLOT1); const bf16* s2 = (const bf16*)(a.ws + WS_SLOT2); const bf16* s3 = (const bf16*)(a.ws + WS_SLOT3);
    const f32x4* wr = (const f32x4*)a.in[I_FNW] + lane;
    constexpr int RF = 4;
    for (int row0 = gw; row0 < T; row0 += RF * NGW) {
        f32x4 v[RF][4]; v2u sa[RF][4][4];
#pragma unroll
        for (int rr = 0; rr < RF; ++rr) { int row = row0 + rr * NGW; row = row < T ? row : T - 1; const f32x4* xr = (const f32x4*)(a.out + (size_t)row * D) + lane;
#pragma unroll
            for (int j = 0; j < 4; ++j) { v[rr][j] = xr[64 * j]; const size_t o = (size_t)row * D + 4 * lane + 256 * j; sa[rr][j][0] = *(const v2u*)(s1 + o); sa[rr][j][1] = *(const v2u*)(s2 + o); sa[rr][j][2] = *(const v2u*)(s3 + o); sa[rr][j][3] = *(const v2u*)(s0 + o); } }
#pragma unroll
        for (int rr = 0; rr < RF; ++rr) { int row = row0 + rr * NGW; row = row < T ? row : T - 1; f32x4* xr = (f32x4*)(a.out + (size_t)row * D) + lane; float s = 0.f;
#pragma unroll
            for (int j = 0; j < 4; ++j) { const v2u a1 = sa[rr][j][0], a2 = sa[rr][j][1], a3 = sa[rr][j][2], a0 = sa[rr][j][3]; f32x4 t = v[rr][j];
                t[0] += (bflo(a0.x) + bflo(a1.x)) + (bflo(a2.x) + bflo(a3.x)); t[1] += (bfhi(a0.x) + bfhi(a1.x)) + (bfhi(a2.x) + bfhi(a3.x)); t[2] += (bflo(a0.y) + bflo(a1.y)) + (bflo(a2.y) + bflo(a3.y)); t[3] += (bfhi(a0.y) + bfhi(a1.y)) + (bfhi(a2.y) + bfhi(a3.y));
                v[rr][j] = t; s += (t[0] * t[0] + t[1] * t[1]) + (t[2] * t[2] + t[3] * t[3]); }
            const float rinv = 1.0f / sqrtf(wave_sum(s) * (1.f / D) + EPS);
            if (row0 + rr * NGW < T) {
#pragma unroll
                for (int j = 0; j < 4; ++j) { const f32x4 ww = wr[64 * j]; xr[64 * j] = v[rr][j] * rinv * ww; } } }
    }
}

constexpr int NPHASES = 12;
__global__ void __launch_bounds__(NTHREADS, 2) fwd(Args a) {
    extern __shared__ __attribute__((aligned(16))) unsigned char lds_raw[];
    LAS unsigned char* lds = (LAS unsigned char*)lds_raw;
    const int wave = __builtin_amdgcn_readfirstlane((int)threadIdx.x >> 6);
    const int G = gridDim.x, wg = blockIdx.x, gw = wg * NWAVES + wave, NGW = G * NWAVES;
    volatile LAS unsigned* misc = (volatile LAS unsigned*)(lds + LDS_BYTES - 64);
    if (wave == 0 && lane_id() < 16) misc[lane_id()] = 0u;
    __syncthreads();
    XcdBarrier bar; bar.bar = (unsigned*)(a.ws + WS_CTL) + CW_BAR; bar.x = 0; bar.st = nullptr; bar.wave = wave;
    if (N_LAUNCHES == 1) bar = xcd_barrier_post((unsigned*)(a.ws + WS_CTL) + CW_BAR, misc, wave);
    const int lo = a.ph_lo, hi = a.ph_hi;
#define IN(k) (lo <= (k) && (k) < hi)
#define SEAM(k) do { if (IN(k) && IN((k) + 1)) { if (N_LAUNCHES == 1) xcd_barrier(bar); } } while (0)
    if (IN(0)) { p0_weights<false>(a, lds, gw, NGW, wave); p0_rows_fast(a, lds, gw, NGW, wave); }
    SEAM(0);
    if (IN(1)) {
        if ((wg >> 3) & 1) { p1_fast(a, lds, wg, G, wave); p0_weights<true>(a, lds, gw, NGW, wave); } else { p0_weights<true>(a, lds, gw, NGW, wave); __syncthreads(); p1_fast(a, lds, wg, G, wave); } }
    SEAM(1);
    if (IN(2)) {
        if ((wg >> 3) & 1) { sc_phase(a, gw, NGW); ssd_state_phase(a, lds, wg, G, wave); } else { ssd_state_phase(a, lds, wg, G, wave); sc_phase(a, gw, NGW); } }
    SEAM(2);
    if (IN(3)) ssd_scan_phase(a, wg, G, wave);
    SEAM(3);
    if (IN(4)) ssd_out_phase(a, lds, wg, G, wave);
    SEAM(4);
    if (IN(5)) p5_fast(a, lds, wg, G, wave);
    SEAM(5);
    if (IN(6)) p6_fast(a, lds, wg, G, wave);
    SEAM(6);
    if (IN(7)) p7_fast(a, lds, wg, G, wave);
    SEAM(7);
    if (IN(8)) p8_fast(a, lds, wg, G, wave);
    SEAM(8);
    if (IN(9)) p9_final(a, gw, NGW);
#undef IN
#undef SEAM
}

extern "C" void kernel_launch(void* const* d_in, const int* in_sizes, int n_in, void* d_out, int out_size, void* d_ws, size_t ws_size, hipStream_t stream) {
    static int grid = 0;
    if (grid == 0) {
        if (n_in != 20 || in_sizes[0] != T * D || out_size != T * D || ws_size < WS_END) { fprintf(stderr, "kernel_launch: unexpected shapes (n_in %d, in0 %d, out %d, ws %zu)\n", n_in, n_in > 0 ? in_sizes[0] : -1, out_size, ws_size); grid = -1; return; }
        int dev = 0, cus = 0, per_cu = 0;
        if (hipGetDevice(&dev) != hipSuccess || hipDeviceGetAttribute(&cus, hipDeviceAttributeMultiprocessorCount, dev) != hipSuccess) { grid = -1; return; }
        if (hipFuncSetAttribute((const void*)fwd, hipFuncAttributeMaxDynamicSharedMemorySize, LDS_BYTES) != hipSuccess) { fprintf(stderr, "kernel_launch: hipFuncSetAttribute failed\n"); grid = -1; return; }
        if (hipOccupancyMaxActiveBlocksPerMultiprocessor(&per_cu, (const void*)fwd, NTHREADS, LDS_BYTES) != hipSuccess || per_cu < 1) fprintf(stderr, "kernel_launch: occupancy query reports %d\n", per_cu);
        (void)hipGetLastError();
        grid = cus;
    }
    if (grid < 0) return;
    (void)hipMemsetAsync((char*)d_ws + WS_CTL, 0, CTL_ZERO_BYTES, stream);
    Args a{};
    for (int i = 0; i < 20; ++i) a.in[i] = (const float*)d_in[i];
    a.out = (float*)d_out; a.ws = (unsigned char*)d_ws;
    if (N_LAUNCHES == 1) { a.ph_lo = 0; a.ph_hi = NPHASES; hipLaunchKernelGGL(fwd, dim3(grid), dim3(NTHREADS), LDS_BYTES, stream, a); }
    else for (int p = 0; p < 10; ++p) { a.ph_lo = p; a.ph_hi = p + 1; hipLaunchKernelGGL(fwd, dim3(grid), dim3(NTHREADS), LDS_BYTES, stream, a); }
}
```
